# Optimizing an MI355X kernel written in HIP

```python
import jax, jax.numpy as jnp
from jax import lax
import numpy as np

D_MODEL = 2048
BATCH = 4
SEQ = 2048
DEPTH = 1

CHUNK = 64
Q_BLOCK = 128
CONV_WIDTH = D_MODEL // 2
CONV_GROUPS = 8
CONV_K = 3
V_DIM = 128
N_HEADS = (D_MODEL - CONV_WIDTH) // V_DIM
QK_NOPE = 128
QK_ROPE = 64
Q_RANK = 768
KV_RANK = 512
ATTN_WIDTH = N_HEADS * V_DIM
MIX_WIDTH = CONV_WIDTH + ATTN_WIDTH
IN_WIDTH = 3 * CONV_WIDTH + Q_RANK + KV_RANK + QK_ROPE
D_FF = 4 * D_MODEL
ROPE_THETA = 10000.0
EPS = 1e-6
NEG_INF = -1e30

kernel_name = "hybrid_conv_mla_sandwich_block"


def rms_norm(x, g):
    x32 = x.astype(jnp.float32)
    y = x32 * lax.rsqrt(jnp.mean(x32 * x32, axis=-1, keepdims=True) + EPS)
    return (y * g.astype(jnp.float32)).astype(x.dtype)


def group_rms_norm(x, g, n_groups):
    b, s, w = x.shape
    y = rms_norm(x.reshape(b, s, n_groups, w // n_groups), g.reshape(n_groups, w // n_groups))
    return y.reshape(b, s, w)


def apply_rope(x, cos, sin):
    x32 = x.astype(jnp.float32)
    x1, x2 = jnp.split(x32, 2, axis=-1)
    return jnp.concatenate([x1 * cos - x2 * sin, x2 * cos + x1 * sin], axis=-1).astype(x.dtype)


def short_conv_causal(u, w):
    rhs = w[:, None, :].astype(u.dtype)
    return lax.conv_general_dilated(
        u, rhs, window_strides=(1,), padding=[(CONV_K - 1, 0)],
        dimension_numbers=("NWC", "WIO", "NWC"), feature_group_count=u.shape[-1])


def chunk_causal_mla(q_nope, q_rope, k_nope, k_rope, v):
    s_len = q_nope.shape[1]
    scale = (QK_NOPE + QK_ROPE) ** -0.5
    chunk_id = jnp.arange(s_len) // CHUNK
    outs = []
    for start in range(0, s_len, Q_BLOCK):
        end = start + Q_BLOCK
        s = (jnp.einsum("bqhd,bkhd->bhqk", q_nope[:, start:end], k_nope[:, :end],
                        preferred_element_type=jnp.float32)
             + jnp.einsum("bqhr,bkr->bhqk", q_rope[:, start:end], k_rope[:, :end],
                          preferred_element_type=jnp.float32)) * scale
        visible = chunk_id[None, :end] <= chunk_id[start:end, None]
        s = jnp.where(visible, s, NEG_INF)
        p = jax.nn.softmax(s, axis=-1).astype(v.dtype)
        outs.append(jnp.einsum("bhqk,bkhd->bqhd", p, v[:, :end]))
    return jnp.concatenate(outs, axis=1)


def hybrid_mixer(h, w_in, conv_w, q_norm_g, w_uq, kv_norm_g, w_ukv, conv_out_g, attn_out_g, w_o):
    b, s, _ = h.shape
    proj = h @ w_in
    cuts = np.cumsum([CONV_WIDTH, CONV_WIDTH, CONV_WIDTH, Q_RANK, KV_RANK]).tolist()
    u, gate_b, gate_c, c_q, c_kv, k_rope_raw = jnp.split(proj, cuts, axis=-1)

    y_conv = gate_b * short_conv_causal(gate_c * u, conv_w)
    y_conv = group_rms_norm(y_conv, conv_out_g, CONV_GROUPS)

    q = (rms_norm(c_q, q_norm_g) @ w_uq).reshape(b, s, N_HEADS, QK_NOPE + QK_ROPE)
    q_nope, q_rope = q[..., :QK_NOPE], q[..., QK_NOPE:]
    kv = (rms_norm(c_kv, kv_norm_g) @ w_ukv).reshape(b, s, N_HEADS, QK_NOPE + V_DIM)
    k_nope, v = kv[..., :QK_NOPE], kv[..., QK_NOPE:]
    pos = jnp.arange(s, dtype=jnp.float32)
    inv_freq = jnp.power(ROPE_THETA, -jnp.arange(0, QK_ROPE, 2, dtype=jnp.float32) / QK_ROPE)
    ang = pos[:, None] * inv_freq[None, :]
    cos, sin = jnp.cos(ang), jnp.sin(ang)
    q_rope = apply_rope(q_rope, cos[None, :, None, :], sin[None, :, None, :])
    k_rope = apply_rope(k_rope_raw, cos[None], sin[None])
    o = chunk_causal_mla(q_nope, q_rope, k_nope, k_rope, v)
    y_attn = group_rms_norm(o.reshape(b, s, ATTN_WIDTH), attn_out_g, N_HEADS)

    return jnp.concatenate([y_conv, y_attn], axis=-1) @ w_o


def setup_inputs(seed: int = 0) -> dict:
    key = jax.random.key(seed)
    ks = jax.random.split(key, 17)

    def w(k, shape, fan_in):
        return jax.random.normal(k, shape, jnp.float32) * (fan_in ** -0.5)

    def gain(k, n):
        return 1.0 + 0.05 * jax.random.normal(k, (DEPTH, n), jnp.float32)

    return {
        "x": jax.random.normal(ks[0], (BATCH, SEQ, D_MODEL), jnp.float32),
        "pre_mix_g": gain(ks[1], D_MODEL),
        "w_in": w(ks[2], (DEPTH, D_MODEL, IN_WIDTH), D_MODEL),
        "conv_w": w(ks[3], (DEPTH, CONV_K, CONV_WIDTH), CONV_K),
        "q_norm_g": gain(ks[4], Q_RANK),
        "w_uq": w(ks[5], (DEPTH, Q_RANK, N_HEADS * (QK_NOPE + QK_ROPE)), Q_RANK),
        "kv_norm_g": gain(ks[6], KV_RANK),
        "w_ukv": w(ks[7], (DEPTH, KV_RANK, N_HEADS * (QK_NOPE + V_DIM)), KV_RANK),
        "conv_out_g": gain(ks[8], CONV_WIDTH),
        "attn_out_g": gain(ks[9], ATTN_WIDTH),
        "w_o": w(ks[10], (DEPTH, MIX_WIDTH, D_MODEL), MIX_WIDTH),
        "post_mix_g": gain(ks[11], D_MODEL),
        "pre_mlp_g": gain(ks[12], D_MODEL),
        "w_up": w(ks[13], (DEPTH, D_MODEL, D_FF), D_MODEL),
        "w_down": w(ks[14], (DEPTH, D_FF, D_MODEL), D_FF),
        "post_mlp_g": gain(ks[15], D_MODEL),
    }


def reference(x, pre_mix_g, w_in, conv_w, q_norm_g, w_uq, kv_norm_g, w_ukv, conv_out_g,
              attn_out_g, w_o, post_mix_g, pre_mlp_g, w_up, w_down, post_mlp_g):
    for l in range(DEPTH):
        h = rms_norm(x, pre_mix_g[l])
        y = hybrid_mixer(h, w_in[l], conv_w[l], q_norm_g[l], w_uq[l], kv_norm_g[l], w_ukv[l],
                         conv_out_g[l], attn_out_g[l], w_o[l])
        x = x + rms_norm(y, post_mix_g[l])
        h = rms_norm(x, pre_mlp_g[l])
        m = jnp.square(jax.nn.relu(h @ w_up[l])) @ w_down[l]
        x = x + rms_norm(m, post_mlp_g[l])
    return x
```

```cpp
#include <hip/hip_runtime.h>
#include <cstdint>
#include <cstdio>
#include <cmath>

constexpr int M = 8192, DM = 2048, SEQ = 2048;
constexpr int CW = 1024, QR = 768, KVR = 512, RD = 64, NH = 8, NOPE = 128, VD = 128, QKD = 192;
constexpr int INW = 4416, INWP = 4608, DFF = 8192, NQ = NH * QKD  , NKV = NH * (NOPE + VD)  ;
constexpr float EPS = 1e-6f;
constexpr float QSCALE = 0.07216878364870322f * 1.4426950408889634f;

constexpr size_t MiB = 1u << 20;
constexpr size_t WS_CTL = 0, WS_TAB = MiB / 4;
constexpr size_t WS_WDN = 1 * MiB, WS_WUP = 33 * MiB, WS_H = 65 * MiB;
constexpr size_t WS_BIG = 97 * MiB;
constexpr size_t WS_PROJ = WS_BIG, WS_MIX = 169 * MiB, WS_CQN = 201 * MiB, WS_CKVN = 213 * MiB, WS_KROPE = 221 * MiB;
constexpr size_t WS_Q = WS_BIG, WS_KN = 121 * MiB, WS_V = 137 * MiB;
constexpr size_t WS_Y = WS_BIG, WS_ACT = WS_BIG, WS_MO = 33 * MiB;
constexpr size_t WS_WIN = 225 * MiB, WS_WO = 243 * MiB, WS_WUQ = 251 * MiB, WS_WUKV = WS_WUQ + (size_t)NQ * QR * 2;
constexpr size_t WS_END = WS_WUKV + (size_t)NKV * KVR * 2;
static_assert(WS_END <= 256 * MiB, "ws map");

typedef unsigned short bf16_t;
typedef float f32x4 __attribute__((ext_vector_type(4)));
typedef float f32x2 __attribute__((ext_vector_type(2)));
typedef unsigned u32x4 __attribute__((ext_vector_type(4)));
typedef unsigned u32x2 __attribute__((ext_vector_type(2)));

struct Params {
    const float* x; const float* pre_mix_g; const float* w_in; const float* conv_w; const float* q_norm_g; const float* w_uq;
    const float* kv_norm_g; const float* w_ukv; const float* conv_out_g; const float* attn_out_g; const float* w_o;
    const float* post_mix_g; const float* pre_mlp_g; const float* w_up; const float* w_down; const float* post_mlp_g;
    float* out; unsigned char* ws;
    double inv_freq[32];
};

__device__ __forceinline__ unsigned f2bf(float f) { unsigned u = __float_as_uint(f); return (u + 0x7fffu + ((u >> 16) & 1u)) >> 16; }
__device__ __forceinline__ unsigned pk2(float lo, float hi) { return f2bf(lo) | (f2bf(hi) << 16); }
__device__ __forceinline__ float bflo(unsigned w) { return __uint_as_float(w << 16); }
__device__ __forceinline__ float bfhi(unsigned w) { return __uint_as_float(w & 0xffff0000u); }
__device__ __forceinline__ float bf1(bf16_t h) { return __uint_as_float(((unsigned)h) << 16); }
__device__ __forceinline__ void unpack8(u32x4 w, float (&v)[8]) {
    v[0] = bflo(w.x); v[1] = bfhi(w.x); v[2] = bflo(w.y); v[3] = bfhi(w.y); v[4] = bflo(w.z); v[5] = bfhi(w.z); v[6] = bflo(w.w); v[7] = bfhi(w.w); }
__device__ __forceinline__ u32x4 pack8(const float (&v)[8]) { u32x4 w; w.x = pk2(v[0], v[1]); w.y = pk2(v[2], v[3]); w.z = pk2(v[4], v[5]); w.w = pk2(v[6], v[7]); return w; }
__device__ __forceinline__ float wave_sum(float v) {
#pragma unroll
    for (int o = 1; o < 64; o <<= 1) v += __shfl_xor(v, o);
    return v;
}
__device__ __forceinline__ float wave_max(float v) {
#pragma unroll
    for (int o = 1; o < 64; o <<= 1) v = fmaxf(v, __shfl_xor(v, o));
    return v;
}

__device__ __forceinline__ int uq_row(int n) {
    const int head = n / QKD, w = n % QKD;
    if (w < NOPE) return n;
    const int r = w - NOPE, half = r >> 5, i = r & 31;
    return head * QKD + NOPE + 8 * (i >> 2) + 4 * half + (i & 3);
}
template <bool QPERM>
__device__ __forceinline__ void transpose_item(const float* __restrict__ W, int K, int N, bf16_t* __restrict__ WT, float* scr, int item, int lane) {
    const int nblk = N / 32, kb = item / nblk, nb = item % nblk, k0 = 64 * kb, n0 = 32 * nb;
#pragma unroll 8
    for (int i = 0; i < 32; ++i) { const int kk = 2 * i + (lane >> 5); scr[kk * 33 + (lane & 31)] = W[(size_t)(k0 + kk) * N + n0 + (lane & 31)]; }
    __builtin_amdgcn_s_waitcnt(0xC07F); asm volatile("" ::: "memory");
    const int c = lane & 7;
#pragma unroll
    for (int j = 0; j < 4; ++j) { const int n = (lane >> 3) + 8 * j; const float* s = scr + (8 * c) * 33 + n;
        u32x4 o; o.x = pk2(s[0 * 33], s[1 * 33]); o.y = pk2(s[2 * 33], s[3 * 33]); o.z = pk2(s[4 * 33], s[5 * 33]); o.w = pk2(s[6 * 33], s[7 * 33]);
        const int orow = QPERM ? uq_row(n0 + n) : (n0 + n);
        *(u32x4*)(WT + (size_t)orow * K + k0 + 8 * c) = o; }
    __builtin_amdgcn_s_waitcnt(0xC07F); asm volatile("" ::: "memory");
}
__device__ __forceinline__ void p0_weights(const Params& p, float* scr, int gw, int ngw, int lane) {
    constexpr int I_IN = (DM / 64) * (INW / 32), I_UQ = (QR / 64) * (NQ / 32), I_UKV = (KVR / 64) * (NKV / 32), I_O = (DM / 64) * (DM / 32),
                  I_UP = (DM / 64) * (DFF / 32), I_DN = (DFF / 64) * (DM / 32);
    constexpr int NITEMS = I_IN + I_UQ + I_UKV + I_O + I_UP + I_DN;
    bf16_t* WinT = (bf16_t*)(p.ws + WS_WIN); bf16_t* WuqT = (bf16_t*)(p.ws + WS_WUQ); bf16_t* WukvT = (bf16_t*)(p.ws + WS_WUKV);
    bf16_t* WoT = (bf16_t*)(p.ws + WS_WO); bf16_t* WupT = (bf16_t*)(p.ws + WS_WUP); bf16_t* WdnT = (bf16_t*)(p.ws + WS_WDN);
    for (int it = gw; it < NITEMS; it += ngw) {
        int r = it;
        if (r < I_IN) { transpose_item<false>(p.w_in, DM, INW, WinT, scr, r, lane); continue; } r -= I_IN;
        if (r < I_UQ) { transpose_item<true>(p.w_uq, QR, NQ, WuqT, scr, r, lane); continue; } r -= I_UQ;
        if (r < I_UKV) { transpose_item<false>(p.w_ukv, KVR, NKV, WukvT, scr, r, lane); continue; } r -= I_UKV;
        if (r < I_O) { transpose_item<false>(p.w_o, DM, DM, WoT, scr, r, lane); continue; } r -= I_O;
        if (r < I_UP) { transpose_item<false>(p.w_up, DM, DFF, WupT, scr, r, lane); continue; } r -= I_UP;
        transpose_item<false>(p.w_down, DFF, DM, WdnT, scr, r, lane);
    }
    for (int c = gw * 64 + lane; c < (INWP - INW) * DM / 8; c += ngw * 64) ((u32x4*)(WinT + (size_t)INW * DM))[c] = (u32x4){0u, 0u, 0u, 0u};
}
__device__ __forceinline__ void p0_table(const Params& p, int gtid, int ngt) {
    f32x2* tab = (f32x2*)(p.ws + WS_TAB);
    for (int e = gtid; e < SEQ * 32; e += ngt) {
        const int pos = e >> 5, i = e & 31;
        const double a = (double)pos * p.inv_freq[i];
        const double kq = __builtin_rint(a * 0.63661977236758134308);
        const double r = __builtin_fma(-kq, 1.57079632679489661923, a) - kq * 6.123233995736766e-17;
        const double r2 = r * r;
        double s = -1.0 / 39916800.0; s = s * r2 + 1.0 / 362880.0; s = s * r2 - 1.0 / 5040.0; s = s * r2 + 1.0 / 120.0; s = s * r2 - 1.0 / 6.0; s = s * r2 * r + r;
        double c = 1.0 / 479001600.0; c = c * r2 - 1.0 / 3628800.0; c = c * r2 + 1.0 / 40320.0; c = c * r2 - 1.0 / 720.0; c = c * r2 + 1.0 / 24.0; c = c * r2 - 0.5; c = c * r2 + 1.0;
        const int q = ((int)(long long)kq) & 3;
        double cs, sn;
        if (q == 0) { cs = c; sn = s; } else if (q == 1) { cs = -s; sn = c; } else if (q == 2) { cs = -c; sn = -s; } else { cs = s; sn = -c; }
        tab[e] = (f32x2){(float)cs, (float)sn};
    }
}
__device__ __forceinline__ void rms_rows_2048(const float* __restrict__ x, const float* __restrict__ g, bf16_t* __restrict__ o, int gw, int ngw, int lane) {
    f32x4 gv[8];
#pragma unroll
    for (int j = 0; j < 8; ++j) gv[j] = ((const f32x4*)g)[lane + 64 * j];
    for (int m = gw; m < M; m += ngw) {
        const f32x4* xr = (const f32x4*)(x + (size_t)m * DM) + lane; f32x4 v[8]; float ss = 0.f;
#pragma unroll
        for (int j = 0; j < 8; ++j) { v[j] = xr[64 * j]; ss += (v[j].x * v[j].x + v[j].y * v[j].y) + (v[j].z * v[j].z + v[j].w * v[j].w); }
        const float r = 1.0f / sqrtf(wave_sum(ss) * (1.0f / DM) + EPS);
        u32x2* o8 = (u32x2*)(o + (size_t)m * DM) + lane;
#pragma unroll
        for (int j = 0; j < 8; ++j) { const f32x4 t = v[j] * r * gv[j]; o8[64 * j] = (u32x2){pk2(t.x, t.y), pk2(t.z, t.w)}; }
    }
}

__device__ __forceinline__ void p2_mixprep(const Params& p, int gw, int ngw, int lane) {
    const bf16_t* PROJ = (const bf16_t*)(p.ws + WS_PROJ); bf16_t* MIX = (bf16_t*)(p.ws + WS_MIX); bf16_t* CQN = (bf16_t*)(p.ws + WS_CQN);
    bf16_t* CKVN = (bf16_t*)(p.ws + WS_CKVN); bf16_t* KROPE = (bf16_t*)(p.ws + WS_KROPE); const f32x2* tab = (const f32x2*)(p.ws + WS_TAB);
    const int c0 = 16 * lane;
    for (int m = gw; m < M; m += ngw) {
        const int t = m & (SEQ - 1);
        const bf16_t* pr = PROJ + (size_t)m * INWP;
        {
            float y[16];
#pragma unroll
            for (int hh = 0; hh < 2; ++hh) {
                const int c = c0 + 8 * hh;
                float u0[8], g0[8], cc0[8], u1[8], cc1[8], u2[8], cc2[8];
                unpack8(*(const u32x4*)(pr + c), u0); unpack8(*(const u32x4*)(pr + CW + c), g0); unpack8(*(const u32x4*)(pr + 2 * CW + c), cc0);
                if (t >= 1) { unpack8(*(const u32x4*)(pr - INWP + c), u1); unpack8(*(const u32x4*)(pr - INWP + 2 * CW + c), cc1); }
                else {
#pragma unroll
                    for (int e = 0; e < 8; ++e) { u1[e] = 0.f; cc1[e] = 0.f; } }
                if (t >= 2) { unpack8(*(const u32x4*)(pr - 2 * INWP + c), u2); unpack8(*(const u32x4*)(pr - 2 * INWP + 2 * CW + c), cc2); }
                else {
#pragma unroll
                    for (int e = 0; e < 8; ++e) { u2[e] = 0.f; cc2[e] = 0.f; } }
                const f32x4 wa0 = *(const f32x4*)(p.conv_w + c), wa1 = *(const f32x4*)(p.conv_w + c + 4);
                const f32x4 wb0 = *(const f32x4*)(p.conv_w + CW + c), wb1 = *(const f32x4*)(p.conv_w + CW + c + 4);
                const f32x4 wc0 = *(const f32x4*)(p.conv_w + 2 * CW + c), wc1 = *(const f32x4*)(p.conv_w + 2 * CW + c + 4);
#pragma unroll
                for (int e = 0; e < 8; ++e) {
                    const float w0 = e < 4 ? wa0[e & 3] : wa1[e & 3], w1 = e < 4 ? wb0[e & 3] : wb1[e & 3], w2 = e < 4 ? wc0[e & 3] : wc1[e & 3];
                    y[8 * hh + e] = g0[e] * (w0 * (cc2[e] * u2[e]) + w1 * (cc1[e] * u1[e]) + w2 * (cc0[e] * u0[e]));
                }
            }
            float ss = 0.f;
#pragma unroll
            for (int e = 0; e < 16; ++e) ss += y[e] * y[e];
            ss += __shfl_xor(ss, 1); ss += __shfl_xor(ss, 2); ss += __shfl_xor(ss, 4);
            const float r = 1.0f / sqrtf(ss * (1.0f / 128.0f) + EPS);
#pragma unroll
            for (int hh = 0; hh < 2; ++hh) {
                const int c = c0 + 8 * hh; const f32x4 ga = *(const f32x4*)(p.conv_out_g + c), gb = *(const f32x4*)(p.conv_out_g + c + 4);
                float o[8];
#pragma unroll
                for (int e = 0; e < 8; ++e) o[e] = y[8 * hh + e] * r * (e < 4 ? ga[e & 3] : gb[e & 3]);
                *(u32x4*)(MIX + (size_t)m * DM + c) = pack8(o);
            }
        }
        {
            float a[8], b[8]; unpack8(*(const u32x4*)(pr + 3 * CW + 8 * lane), a);
            const bool two = lane < 32;
            if (two) unpack8(*(const u32x4*)(pr + 3 * CW + 8 * (64 + lane)), b);
            else {
#pragma unroll
                for (int e = 0; e < 8; ++e) b[e] = 0.f; }
            float ss = 0.f;
#pragma unroll
            for (int e = 0; e < 8; ++e) ss += a[e] * a[e] + b[e] * b[e];
            const float r = 1.0f / sqrtf(wave_sum(ss) * (1.0f / QR) + EPS);
            { const f32x4 ga = *(const f32x4*)(p.q_norm_g + 8 * lane), gb = *(const f32x4*)(p.q_norm_g + 8 * lane + 4); float o[8];
#pragma unroll
              for (int e = 0; e < 8; ++e) o[e] = a[e] * r * (e < 4 ? ga[e & 3] : gb[e & 3]);
              *(u32x4*)(CQN + (size_t)m * QR + 8 * lane) = pack8(o); }
            if (two) { const int cc = 8 * (64 + lane); const f32x4 ga = *(const f32x4*)(p.q_norm_g + cc), gb = *(const f32x4*)(p.q_norm_g + cc + 4); float o[8];
#pragma unroll
              for (int e = 0; e < 8; ++e) o[e] = b[e] * r * (e < 4 ? ga[e & 3] : gb[e & 3]);
              *(u32x4*)(CQN + (size_t)m * QR + cc) = pack8(o); }
        }
        {
            float a[8]; unpack8(*(const u32x4*)(pr + 3 * CW + QR + 8 * lane), a); float ss = 0.f;
#pragma unroll
            for (int e = 0; e < 8; ++e) ss += a[e] * a[e];
            const float r = 1.0f / sqrtf(wave_sum(ss) * (1.0f / KVR) + EPS);
            const f32x4 ga = *(const f32x4*)(p.kv_norm_g + 8 * lane), gb = *(const f32x4*)(p.kv_norm_g + 8 * lane + 4); float o[8];
#pragma unroll
            for (int e = 0; e < 8; ++e) o[e] = a[e] * r * (e < 4 ? ga[e & 3] : gb[e & 3]);
            *(u32x4*)(CKVN + (size_t)m * KVR + 8 * lane) = pack8(o);
        }
        {
            const float xv = bf1(pr[3 * CW + QR + KVR + lane]); const float pv = __shfl_xor(xv, 32);
            const f32x2 cs = tab[t * 32 + (lane & 31)];
            const float o = lane < 32 ? (xv * cs.x - pv * cs.y) : (xv * cs.x + pv * cs.y);
            KROPE[(size_t)m * RD + lane] = (bf16_t)f2bf(o);
        }
    }
}

__device__ __forceinline__ void p6_postmix(const Params& p, int gw, int ngw, int lane) {
    const float* Y = (const float*)(p.ws + WS_Y); bf16_t* H = (bf16_t*)(p.ws + WS_H);
    for (int m = gw; m < M; m += ngw) {
        const f32x4* yr = (const f32x4*)(Y + (size_t)m * DM) + lane; const f32x4* xr = (const f32x4*)(p.x + (size_t)m * DM) + lane;
        f32x4 v[8]; float ss = 0.f;
#pragma unroll
        for (int j = 0; j < 8; ++j) { v[j] = yr[64 * j]; ss += (v[j].x * v[j].x + v[j].y * v[j].y) + (v[j].z * v[j].z + v[j].w * v[j].w); }
        const float r1 = 1.0f / sqrtf(wave_sum(ss) * (1.0f / DM) + EPS);
        float s2 = 0.f; f32x4* orow = (f32x4*)(p.out + (size_t)m * DM) + lane;
#pragma unroll
        for (int j = 0; j < 8; ++j) { const f32x4 g = ((const f32x4*)p.post_mix_g)[lane + 64 * j]; v[j] = xr[64 * j] + v[j] * r1 * g; orow[64 * j] = v[j];
            s2 += (v[j].x * v[j].x + v[j].y * v[j].y) + (v[j].z * v[j].z + v[j].w * v[j].w); }
        const float r2 = 1.0f / sqrtf(wave_sum(s2) * (1.0f / DM) + EPS);
        u32x2* o8 = (u32x2*)(H + (size_t)m * DM) + lane;
#pragma unroll
        for (int j = 0; j < 8; ++j) { const f32x4 g = ((const f32x4*)p.pre_mlp_g)[lane + 64 * j]; const f32x4 t = v[j] * r2 * g; o8[64 * j] = (u32x2){pk2(t.x, t.y), pk2(t.z, t.w)}; }
    }
}
__device__ __forceinline__ void p9_final(const Params& p, int gw, int ngw, int lane) {
    const float* MO = (const float*)(p.ws + WS_MO);
    for (int m = gw; m < M; m += ngw) {
        const f32x4* yr = (const f32x4*)(MO + (size_t)m * DM) + lane; f32x4* orow = (f32x4*)(p.out + (size_t)m * DM) + lane;
        f32x4 v[8]; float ss = 0.f;
#pragma unroll
        for (int j = 0; j < 8; ++j) { v[j] = yr[64 * j]; ss += (v[j].x * v[j].x + v[j].y * v[j].y) + (v[j].z * v[j].z + v[j].w * v[j].w); }
        const float r1 = 1.0f / sqrtf(wave_sum(ss) * (1.0f / DM) + EPS);
#pragma unroll
        for (int j = 0; j < 8; ++j) { const f32x4 g = ((const f32x4*)p.post_mlp_g)[lane + 64 * j]; orow[64 * j] = orow[64 * j] + v[j] * r1 * g; }
    }
}

struct EpiProj { bf16_t* O; __device__ __forceinline__ void operator()(int row, int col, const float (&v)[8]) const { *(u32x4*)(O + (size_t)row * INWP + col) = pack8(v); } };
struct EpiKV { bf16_t* KN; bf16_t* V;
    __device__ __forceinline__ void operator()(int row, int col, const float (&v)[8]) const {
        const int head = col >> 8, w = col & 255; bf16_t* dst = (w < NOPE ? KN : V) + (size_t)row * (NH * NOPE) + head * NOPE + (w & 127); *(u32x4*)dst = pack8(v); } };
struct EpiQ { bf16_t* Q; const f32x2* tab;
    __device__ __forceinline__ void operator()(int row, int col, const float (&v)[8]) const {
        const int head = col / QKD, w = col - head * QKD; bf16_t* dst = Q + (size_t)row * NQ + head * QKD;
        if (w < NOPE) { float o[8];
#pragma unroll
            for (int e = 0; e < 8; ++e) o[e] = v[e] * QSCALE;
            *(u32x4*)(dst + w) = pack8(o); }
        else { const int g = (w - NOPE) >> 3, pos = row & (SEQ - 1); const f32x4* tp = (const f32x4*)(tab + pos * 32 + 4 * g); const f32x4 t0 = tp[0], t1 = tp[1];
            const float c[4] = {t0.x, t0.z, t1.x, t1.z}, s[4] = {t0.y, t0.w, t1.y, t1.w}; float o1[4], o2[4];
#pragma unroll
            for (int e = 0; e < 4; ++e) { o1[e] = (v[e] * c[e] - v[4 + e] * s[e]) * QSCALE; o2[e] = (v[4 + e] * c[e] + v[e] * s[e]) * QSCALE; }
            *(u32x2*)(dst + NOPE + 4 * g) = (u32x2){pk2(o1[0], o1[1]), pk2(o1[2], o1[3])};
            *(u32x2*)(dst + NOPE + 32 + 4 * g) = (u32x2){pk2(o2[0], o2[1]), pk2(o2[2], o2[3])}; }
    } };
struct EpiF32 { float* O; int ld;
    __device__ __forceinline__ void operator()(int row, int col, const float (&v)[8]) const {
        f32x4* d = (f32x4*)(O + (size_t)row * ld + col); d[0] = (f32x4){v[0], v[1], v[2], v[3]}; d[1] = (f32x4){v[4], v[5], v[6], v[7]}; } };
struct EpiRelu2 { bf16_t* O;
    __device__ __forceinline__ void operator()(int row, int col, const float (&v)[8]) const { float o[8];
#pragma unroll
        for (int e = 0; e < 8; ++e) { const float r = fmaxf(v[e], 0.f); o[e] = r * r; }
        *(u32x4*)(O + (size_t)row * DFF + col) = pack8(o); } };

template <class Epi>
__global__ __launch_bounds__(256) void ngemm(const bf16_t* __restrict__ A, const bf16_t* __restrict__ Bt, int K, Epi E) {
    __shared__ __attribute__((aligned(16))) float As[32][68];
    __shared__ __attribute__((aligned(16))) float Bs[32][132];
    const int tid = threadIdx.x, ty = tid >> 4, tx = tid & 15, m0 = blockIdx.y * 64, n0 = blockIdx.x * 128;
    float acc[4][8];
#pragma unroll
    for (int i = 0; i < 4; ++i)
#pragma unroll
        for (int j = 0; j < 8; ++j) acc[i][j] = 0.f;
    for (int k0 = 0; k0 < K; k0 += 32) {
        { const int row = tid >> 2, kc = (tid & 3) * 8; float a[8]; unpack8(*(const u32x4*)(A + (size_t)(m0 + row) * K + k0 + kc), a);
#pragma unroll
          for (int e = 0; e < 8; ++e) As[kc + e][row] = a[e]; }
#pragma unroll
        for (int i = 0; i < 2; ++i) { const int idx = tid + 256 * i, row = idx >> 2, kc = (idx & 3) * 8; float b[8]; unpack8(*(const u32x4*)(Bt + (size_t)(n0 + row) * K + k0 + kc), b);
#pragma unroll
          for (int e = 0; e < 8; ++e) Bs[kc + e][row] = b[e]; }
        __syncthreads();
#pragma unroll 8
        for (int k = 0; k < 32; ++k) {
            const f32x4 a4 = *(const f32x4*)&As[k][ty * 4]; const f32x4 b0 = *(const f32x4*)&Bs[k][tx * 8], b1 = *(const f32x4*)&Bs[k][tx * 8 + 4];
#pragma unroll
            for (int i = 0; i < 4; ++i) {
#pragma unroll
                for (int j = 0; j < 4; ++j) { acc[i][j] += a4[i] * b0[j]; acc[i][4 + j] += a4[i] * b1[j]; } }
        }
        __syncthreads();
    }
#pragma unroll
    for (int i = 0; i < 4; ++i) E(m0 + ty * 4 + i, n0 + tx * 8, acc[i]);
}

__global__ __launch_bounds__(256) void nattn(Params p) {
    __shared__ float qs_[4][QKD]; __shared__ float ps_[4][SEQ];
    const int lane = threadIdx.x & 63, w = threadIdx.x >> 6; const int idx = blockIdx.x * 4 + w; const int m = idx >> 3, h = idx & 7, b = m / SEQ, t = m % SEQ;
    const bf16_t* Q = (const bf16_t*)(p.ws + WS_Q); const bf16_t* KN = (const bf16_t*)(p.ws + WS_KN); const bf16_t* V = (const bf16_t*)(p.ws + WS_V);
    const bf16_t* KR = (const bf16_t*)(p.ws + WS_KROPE); bf16_t* MIX = (bf16_t*)(p.ws + WS_MIX);
    float* qs = qs_[w]; float* ps = ps_[w];
    for (int i = 0; i < 3; ++i) qs[lane + 64 * i] = bf1(Q[(size_t)m * NQ + h * QKD + lane + 64 * i]);
    __syncthreads();
    const int nk = ((t >> 6) + 1) * 64; float mx = -1e30f;
    for (int key = lane; key < nk; key += 64) {
        const size_t km = (size_t)b * SEQ + key; float s = 0.f;
        for (int c = 0; c < 16; ++c) { float kv[8]; unpack8(*(const u32x4*)(KN + km * (NH * NOPE) + h * NOPE + 8 * c), kv);
#pragma unroll
            for (int e = 0; e < 8; ++e) s += qs[8 * c + e] * kv[e]; }
        for (int c = 0; c < 8; ++c) { float kv[8]; unpack8(*(const u32x4*)(KR + km * RD + 8 * c), kv);
#pragma unroll
            for (int e = 0; e < 8; ++e) s += qs[NOPE + 8 * c + e] * kv[e]; }
        ps[key] = s; mx = fmaxf(mx, s);
    }
    mx = wave_max(mx); float l = 0.f;
    for (int key = lane; key < nk; key += 64) { const float e = exp2f(ps[key] - mx); ps[key] = e; l += e; }
    l = wave_sum(l);
    __syncthreads();
    float o0 = 0.f, o1 = 0.f;
    for (int key = 0; key < nk; ++key) { const float pk = ps[key]; const unsigned vv = *(const unsigned*)(V + ((size_t)b * SEQ + key) * (NH * VD) + h * VD + 2 * lane); o0 += pk * bflo(vv); o1 += pk * bfhi(vv); }
    o0 /= l; o1 /= l;
    const float ss = wave_sum(o0 * o0 + o1 * o1); const float r = 1.0f / sqrtf(ss * (1.0f / VD) + EPS);
    const float g0 = p.attn_out_g[h * VD + 2 * lane], g1 = p.attn_out_g[h * VD + 2 * lane + 1];
    *(unsigned*)(MIX + (size_t)m * DM + CW + h * VD + 2 * lane) = pk2(o0 * r * g0, o1 * r * g1);
}

__global__ __launch_bounds__(256) void k_p0(Params p) {
    __shared__ float scr[4][64 * 33];
    const int lane = threadIdx.x & 63, w = threadIdx.x >> 6, gw = blockIdx.x * 4 + w, ngw = gridDim.x * 4;
    p0_weights(p, scr[w], gw, ngw, lane);
    p0_table(p, blockIdx.x * 256 + threadIdx.x, gridDim.x * 256);
    rms_rows_2048(p.x, p.pre_mix_g, (bf16_t*)(p.ws + WS_H), gw, ngw, lane);
}
__global__ __launch_bounds__(256) void k_p2(Params p) { p2_mixprep(p, blockIdx.x * 4 + (threadIdx.x >> 6), gridDim.x * 4, threadIdx.x & 63); }
__global__ __launch_bounds__(256) void k_p6(Params p) { p6_postmix(p, blockIdx.x * 4 + (threadIdx.x >> 6), gridDim.x * 4, threadIdx.x & 63); }
__global__ __launch_bounds__(256) void k_p9(Params p) { p9_final(p, blockIdx.x * 4 + (threadIdx.x >> 6), gridDim.x * 4, threadIdx.x & 63); }

extern "C" void kernel_launch(void* const* d_in, const int* in_sizes, int n_in, void* d_out, int out_size, void* d_ws, size_t ws_size, hipStream_t stream) {
    if (n_in != 16 || in_sizes[0] != M * DM || out_size != M * DM || ws_size < WS_END) { fprintf(stderr, "kernel_launch: unexpected shapes (n_in %d, in0 %d, out %d, ws %zu)\n", n_in, n_in > 0 ? in_sizes[0] : -1, out_size, ws_size); return; }
    Params p{};
    const float** f = (const float**)&p;
    for (int i = 0; i < 16; ++i) f[i] = (const float*)d_in[i];
    p.out = (float*)d_out; p.ws = (unsigned char*)d_ws;
    for (int i = 0; i < 32; ++i) p.inv_freq[i] = pow(10000.0, -(2.0 * i) / 64.0);
    unsigned char* ws = p.ws;
    hipLaunchKernelGGL(k_p0, dim3(2048), dim3(256), 0, stream, p);
    hipLaunchKernelGGL(ngemm<EpiProj>, dim3(INWP / 128, M / 64), dim3(256), 0, stream, (const bf16_t*)(ws + WS_H), (const bf16_t*)(ws + WS_WIN), DM, EpiProj{(bf16_t*)(ws + WS_PROJ)});
    hipLaunchKernelGGL(k_p2, dim3(2048), dim3(256), 0, stream, p);
    hipLaunchKernelGGL(ngemm<EpiKV>, dim3(NKV / 128, M / 64), dim3(256), 0, stream, (const bf16_t*)(ws + WS_CKVN), (const bf16_t*)(ws + WS_WUKV), KVR, EpiKV{(bf16_t*)(ws + WS_KN), (bf16_t*)(ws + WS_V)});
    hipLaunchKernelGGL(ngemm<EpiQ>, dim3(NQ / 128, M / 64), dim3(256), 0, stream, (const bf16_t*)(ws + WS_CQN), (const bf16_t*)(ws + WS_WUQ), QR, EpiQ{(bf16_t*)(ws + WS_Q), (const f32x2*)(ws + WS_TAB)});
    hipLaunchKernelGGL(nattn, dim3(M * NH / 4), dim3(256), 0, stream, p);
    hipLaunchKernelGGL(ngemm<EpiF32>, dim3(DM / 128, M / 64), dim3(256), 0, stream, (const bf16_t*)(ws + WS_MIX), (const bf16_t*)(ws + WS_WO), DM, EpiF32{(float*)(ws + WS_Y), DM});
    hipLaunchKernelGGL(k_p6, dim3(2048), dim3(256), 0, stream, p);
    hipLaunchKernelGGL(ngemm<EpiRelu2>, dim3(DFF / 128, M / 64), dim3(256), 0, stream, (const bf16_t*)(ws + WS_H), (const bf16_t*)(ws + WS_WUP), DM, EpiRelu2{(bf16_t*)(ws + WS_ACT)});
    hipLaunchKernelGGL(ngemm<EpiF32>, dim3(DM / 128, M / 64), dim3(256), 0, stream, (const bf16_t*)(ws + WS_ACT), (const bf16_t*)(ws + WS_WDN), DFF, EpiF32{(float*)(ws + WS_MO), DM});
    hipLaunchKernelGGL(k_p9, dim3(2048), dim3(256), 0, stream, p);
}
```

```cpp
#define MK_PER_PHASE 0
#include <hip/hip_runtime.h>
#include <cstdint>
#include <cstdio>
#include <cmath>

constexpr int M = 8192, DM = 2048, SEQ = 2048;
constexpr int CW = 1024, QR = 768, KVR = 512, RD = 64, NH = 8, NOPE = 128, VD = 128, QKD = 192;
constexpr int INW = 4416, INWP = 4608, DFF = 8192, NQ = NH * QKD  , NKV = NH * (NOPE + VD)  ;
constexpr float EPS = 1e-6f;
constexpr float QSCALE = 0.07216878364870322f * 1.4426950408889634f;

constexpr size_t MiB = 1u << 20;
constexpr size_t WS_CTL = 0, WS_TAB = MiB / 4;
constexpr size_t WS_WDN = 1 * MiB, WS_WUP = 33 * MiB, WS_H = 65 * MiB;
constexpr size_t WS_BIG = 97 * MiB;
constexpr size_t WS_PROJ = WS_BIG, WS_MIX = 169 * MiB, WS_CQN = 201 * MiB, WS_CKVN = 213 * MiB, WS_KROPE = 221 * MiB;
constexpr size_t WS_Q = WS_BIG, WS_KN = 121 * MiB, WS_V = 137 * MiB;
constexpr size_t WS_Y = WS_BIG, WS_ACT = WS_BIG, WS_MO = 33 * MiB;
constexpr size_t WS_WIN = 225 * MiB, WS_WO = 243 * MiB, WS_WUQ = 251 * MiB, WS_WUKV = WS_WUQ + (size_t)NQ * QR * 2;
constexpr size_t WS_END = WS_WUKV + (size_t)NKV * KVR * 2;
static_assert(WS_END <= 256 * MiB, "ws map");

typedef unsigned short bf16_t;
typedef float f32x4 __attribute__((ext_vector_type(4)));
typedef float f32x2 __attribute__((ext_vector_type(2)));
typedef unsigned u32x4 __attribute__((ext_vector_type(4)));
typedef unsigned u32x2 __attribute__((ext_vector_type(2)));
#define LAS __attribute__((address_space(3)))
#define GAS __attribute__((address_space(1)))
typedef LAS float lds_float;

struct Params {
    const float* x; const float* pre_mix_g; const float* w_in; const float* conv_w; const float* q_norm_g; const float* w_uq;
    const float* kv_norm_g; const float* w_ukv; const float* conv_out_g; const float* attn_out_g; const float* w_o;
    const float* post_mix_g; const float* pre_mlp_g; const float* w_up; const float* w_down; const float* post_mlp_g;
    float* out; unsigned char* ws;
    double inv_freq[32];
};

__device__ __forceinline__ unsigned f2bf(float f) { unsigned u = __float_as_uint(f); return (u + 0x7fffu + ((u >> 16) & 1u)) >> 16; }
__device__ __forceinline__ unsigned pk2(float lo, float hi) { return f2bf(lo) | (f2bf(hi) << 16); }
__device__ __forceinline__ float bflo(unsigned w) { return __uint_as_float(w << 16); }
__device__ __forceinline__ float bfhi(unsigned w) { return __uint_as_float(w & 0xffff0000u); }
__device__ __forceinline__ float bf1(bf16_t h) { return __uint_as_float(((unsigned)h) << 16); }
__device__ __forceinline__ void unpack8(u32x4 w, float (&v)[8]) {
    v[0] = bflo(w.x); v[1] = bfhi(w.x); v[2] = bflo(w.y); v[3] = bfhi(w.y); v[4] = bflo(w.z); v[5] = bfhi(w.z); v[6] = bflo(w.w); v[7] = bfhi(w.w); }
__device__ __forceinline__ u32x4 pack8(const float (&v)[8]) { u32x4 w; w.x = pk2(v[0], v[1]); w.y = pk2(v[2], v[3]); w.z = pk2(v[4], v[5]); w.w = pk2(v[6], v[7]); return w; }
__device__ __forceinline__ float wave_sum(float v) {
#pragma unroll
    for (int o = 1; o < 64; o <<= 1) v += __shfl_xor(v, o);
    return v;
}
__device__ __forceinline__ float wave_max(float v) {
#pragma unroll
    for (int o = 1; o < 64; o <<= 1) v = fmaxf(v, __shfl_xor(v, o));
    return v;
}

__device__ __forceinline__ int uq_row(int n) {
    const int head = n / QKD, w = n % QKD;
    if (w < NOPE) return n;
    const int r = w - NOPE, half = r >> 5, i = r & 31;
    return head * QKD + NOPE + 8 * (i >> 2) + 4 * half + (i & 3);
}
template <bool QPERM>
__device__ __forceinline__ void transpose_item(const float* __restrict__ W, int K, int N, bf16_t* __restrict__ WT, lds_float* scr, int item, int lane) {
    const int nblk = N / 32, kb = item / nblk, nb = item % nblk, k0 = 64 * kb, n0 = 32 * nb;
#pragma unroll 8
    for (int i = 0; i < 32; ++i) { const int kk = 2 * i + (lane >> 5); scr[kk * 33 + (lane & 31)] = W[(size_t)(k0 + kk) * N + n0 + (lane & 31)]; }
    __builtin_amdgcn_s_waitcnt(0xC07F); asm volatile("" ::: "memory");
    const int c = lane & 7;
#pragma unroll
    for (int j = 0; j < 4; ++j) { const int n = (lane >> 3) + 8 * j; const lds_float* s = scr + (8 * c) * 33 + n;
        u32x4 o; o.x = pk2(s[0 * 33], s[1 * 33]); o.y = pk2(s[2 * 33], s[3 * 33]); o.z = pk2(s[4 * 33], s[5 * 33]); o.w = pk2(s[6 * 33], s[7 * 33]);
        const int orow = QPERM ? uq_row(n0 + n) : (n0 + n);
        *(u32x4*)(WT + (size_t)orow * K + k0 + 8 * c) = o; }
    __builtin_amdgcn_s_waitcnt(0xC07F); asm volatile("" ::: "memory");
}
__device__ __forceinline__ void p0_weights(const Params& p, lds_float* scr, int gw, int ngw, int lane) {
    constexpr int I_IN = (DM / 64) * (INW / 32), I_UQ = (QR / 64) * (NQ / 32), I_UKV = (KVR / 64) * (NKV / 32), I_O = (DM / 64) * (DM / 32),
                  I_UP = (DM / 64) * (DFF / 32), I_DN = (DFF / 64) * (DM / 32);
    constexpr int NITEMS = I_IN + I_UQ + I_UKV + I_O + I_UP + I_DN;
    bf16_t* WinT = (bf16_t*)(p.ws + WS_WIN); bf16_t* WuqT = (bf16_t*)(p.ws + WS_WUQ); bf16_t* WukvT = (bf16_t*)(p.ws + WS_WUKV);
    bf16_t* WoT = (bf16_t*)(p.ws + WS_WO); bf16_t* WupT = (bf16_t*)(p.ws + WS_WUP); bf16_t* WdnT = (bf16_t*)(p.ws + WS_WDN);
    for (int it = gw; it < NITEMS; it += ngw) {
        int r = it;
        if (r < I_IN) { transpose_item<false>(p.w_in, DM, INW, WinT, scr, r, lane); continue; } r -= I_IN;
        if (r < I_UQ) { transpose_item<true>(p.w_uq, QR, NQ, WuqT, scr, r, lane); continue; } r -= I_UQ;
        if (r < I_UKV) { transpose_item<false>(p.w_ukv, KVR, NKV, WukvT, scr, r, lane); continue; } r -= I_UKV;
        if (r < I_O) { transpose_item<false>(p.w_o, DM, DM, WoT, scr, r, lane); continue; } r -= I_O;
        if (r < I_UP) { transpose_item<false>(p.w_up, DM, DFF, WupT, scr, r, lane); continue; } r -= I_UP;
        transpose_item<false>(p.w_down, DFF, DM, WdnT, scr, r, lane);
    }
    for (int c = gw * 64 + lane; c < (INWP - INW) * DM / 8; c += ngw * 64) ((u32x4*)(WinT + (size_t)INW * DM))[c] = (u32x4){0u, 0u, 0u, 0u};
}
__device__ __forceinline__ void p0_table(const Params& p, int gtid, int ngt) {
    f32x2* tab = (f32x2*)(p.ws + WS_TAB);
    for (int e = gtid; e < SEQ * 32; e += ngt) {
        const int pos = e >> 5, i = e & 31;
        const double a = (double)pos * p.inv_freq[i];
        const double kq = __builtin_rint(a * 0.63661977236758134308);
        const double r = __builtin_fma(-kq, 1.57079632679489661923, a) - kq * 6.123233995736766e-17;
        const double r2 = r * r;
        double s = -1.0 / 39916800.0; s = s * r2 + 1.0 / 362880.0; s = s * r2 - 1.0 / 5040.0; s = s * r2 + 1.0 / 120.0; s = s * r2 - 1.0 / 6.0; s = s * r2 * r + r;
        double c = 1.0 / 479001600.0; c = c * r2 - 1.0 / 3628800.0; c = c * r2 + 1.0 / 40320.0; c = c * r2 - 1.0 / 720.0; c = c * r2 + 1.0 / 24.0; c = c * r2 - 0.5; c = c * r2 + 1.0;
        const int q = ((int)(long long)kq) & 3;
        double cs, sn;
        if (q == 0) { cs = c; sn = s; } else if (q == 1) { cs = -s; sn = c; } else if (q == 2) { cs = -c; sn = -s; } else { cs = s; sn = -c; }
        tab[e] = (f32x2){(float)cs, (float)sn};
    }
}
__device__ __forceinline__ void rms_rows_2048(const float* __restrict__ x, const float* __restrict__ g, bf16_t* __restrict__ o, int gw, int ngw, int lane) {
    f32x4 gv[8];
#pragma unroll
    for (int j = 0; j < 8; ++j) gv[j] = ((const f32x4*)g)[lane + 64 * j];
    for (int m = gw; m < M; m += ngw) {
        const f32x4* xr = (const f32x4*)(x + (size_t)m * DM) + lane; f32x4 v[8]; float ss = 0.f;
#pragma unroll
        for (int j = 0; j < 8; ++j) { v[j] = xr[64 * j]; ss += (v[j].x * v[j].x + v[j].y * v[j].y) + (v[j].z * v[j].z + v[j].w * v[j].w); }
        const float r = 1.0f / sqrtf(wave_sum(ss) * (1.0f / DM) + EPS);
        u32x2* o8 = (u32x2*)(o + (size_t)m * DM) + lane;
#pragma unroll
        for (int j = 0; j < 8; ++j) { const f32x4 t = v[j] * r * gv[j]; o8[64 * j] = (u32x2){pk2(t.x, t.y), pk2(t.z, t.w)}; }
    }
}

__device__ __forceinline__ void p2_mixprep(const Params& p, int gw, int ngw, int lane) {
    const bf16_t* PROJ = (const bf16_t*)(p.ws + WS_PROJ); bf16_t* MIX = (bf16_t*)(p.ws + WS_MIX); bf16_t* CQN = (bf16_t*)(p.ws + WS_CQN);
    bf16_t* CKVN = (bf16_t*)(p.ws + WS_CKVN); bf16_t* KROPE = (bf16_t*)(p.ws + WS_KROPE); const f32x2* tab = (const f32x2*)(p.ws + WS_TAB);
    const int c0 = 16 * lane;
    for (int m = gw; m < M; m += ngw) {
        const int t = m & (SEQ - 1);
        const bf16_t* pr = PROJ + (size_t)m * INWP;
        {
            float y[16];
#pragma unroll
            for (int hh = 0; hh < 2; ++hh) {
                const int c = c0 + 8 * hh;
                float u0[8], g0[8], cc0[8], u1[8], cc1[8], u2[8], cc2[8];
                unpack8(*(const u32x4*)(pr + c), u0); unpack8(*(const u32x4*)(pr + CW + c), g0); unpack8(*(const u32x4*)(pr + 2 * CW + c), cc0);
                if (t >= 1) { unpack8(*(const u32x4*)(pr - INWP + c), u1); unpack8(*(const u32x4*)(pr - INWP + 2 * CW + c), cc1); }
                else {
#pragma unroll
                    for (int e = 0; e < 8; ++e) { u1[e] = 0.f; cc1[e] = 0.f; } }
                if (t >= 2) { unpack8(*(const u32x4*)(pr - 2 * INWP + c), u2); unpack8(*(const u32x4*)(pr - 2 * INWP + 2 * CW + c), cc2); }
                else {
#pragma unroll
                    for (int e = 0; e < 8; ++e) { u2[e] = 0.f; cc2[e] = 0.f; } }
                const f32x4 wa0 = *(const f32x4*)(p.conv_w + c), wa1 = *(const f32x4*)(p.conv_w + c + 4);
                const f32x4 wb0 = *(const f32x4*)(p.conv_w + CW + c), wb1 = *(const f32x4*)(p.conv_w + CW + c + 4);
                const f32x4 wc0 = *(const f32x4*)(p.conv_w + 2 * CW + c), wc1 = *(const f32x4*)(p.conv_w + 2 * CW + c + 4);
#pragma unroll
                for (int e = 0; e < 8; ++e) {
                    const float w0 = e < 4 ? wa0[e & 3] : wa1[e & 3], w1 = e < 4 ? wb0[e & 3] : wb1[e & 3], w2 = e < 4 ? wc0[e & 3] : wc1[e & 3];
                    y[8 * hh + e] = g0[e] * (w0 * (cc2[e] * u2[e]) + w1 * (cc1[e] * u1[e]) + w2 * (cc0[e] * u0[e]));
                }
            }
            float ss = 0.f;
#pragma unroll
            for (int e = 0; e < 16; ++e) ss += y[e] * y[e];
            ss += __shfl_xor(ss, 1); ss += __shfl_xor(ss, 2); ss += __shfl_xor(ss, 4);
            const float r = 1.0f / sqrtf(ss * (1.0f / 128.0f) + EPS);
#pragma unroll
            for (int hh = 0; hh < 2; ++hh) {
                const int c = c0 + 8 * hh; const f32x4 ga = *(const f32x4*)(p.conv_out_g + c), gb = *(const f32x4*)(p.conv_out_g + c + 4);
                float o[8];
#pragma unroll
                for (int e = 0; e < 8; ++e) o[e] = y[8 * hh + e] * r * (e < 4 ? ga[e & 3] : gb[e & 3]);
                *(u32x4*)(MIX + (size_t)m * DM + c) = pack8(o);
            }
        }
        {
            float a[8], b[8]; unpack8(*(const u32x4*)(pr + 3 * CW + 8 * lane), a);
            const bool two = lane < 32;
            if (two) unpack8(*(const u32x4*)(pr + 3 * CW + 8 * (64 + lane)), b);
            else {
#pragma unroll
                for (int e = 0; e < 8; ++e) b[e] = 0.f; }
            float ss = 0.f;
#pragma unroll
            for (int e = 0; e < 8; ++e) ss += a[e] * a[e] + b[e] * b[e];
            const float r = 1.0f / sqrtf(wave_sum(ss) * (1.0f / QR) + EPS);
            { const f32x4 ga = *(const f32x4*)(p.q_norm_g + 8 * lane), gb = *(const f32x4*)(p.q_norm_g + 8 * lane + 4); float o[8];
#pragma unroll
              for (int e = 0; e < 8; ++e) o[e] = a[e] * r * (e < 4 ? ga[e & 3] : gb[e & 3]);
              *(u32x4*)(CQN + (size_t)m * QR + 8 * lane) = pack8(o); }
            if (two) { const int cc = 8 * (64 + lane); const f32x4 ga = *(const f32x4*)(p.q_norm_g + cc), gb = *(const f32x4*)(p.q_norm_g + cc + 4); float o[8];
#pragma unroll
              for (int e = 0; e < 8; ++e) o[e] = b[e] * r * (e < 4 ? ga[e & 3] : gb[e & 3]);
              *(u32x4*)(CQN + (size_t)m * QR + cc) = pack8(o); }
        }
        {
            float a[8]; unpack8(*(const u32x4*)(pr + 3 * CW + QR + 8 * lane), a); float ss = 0.f;
#pragma unroll
            for (int e = 0; e < 8; ++e) ss += a[e] * a[e];
            const float r = 1.0f / sqrtf(wave_sum(ss) * (1.0f / KVR) + EPS);
            const f32x4 ga = *(const f32x4*)(p.kv_norm_g + 8 * lane), gb = *(const f32x4*)(p.kv_norm_g + 8 * lane + 4); float o[8];
#pragma unroll
            for (int e = 0; e < 8; ++e) o[e] = a[e] * r * (e < 4 ? ga[e & 3] : gb[e & 3]);
            *(u32x4*)(CKVN + (size_t)m * KVR + 8 * lane) = pack8(o);
        }
        {
            const float xv = bf1(pr[3 * CW + QR + KVR + lane]); const float pv = __shfl_xor(xv, 32);
            const f32x2 cs = tab[t * 32 + (lane & 31)];
            const float o = lane < 32 ? (xv * cs.x - pv * cs.y) : (xv * cs.x + pv * cs.y);
            KROPE[(size_t)m * RD + lane] = (bf16_t)f2bf(o);
        }
    }
}

__device__ __forceinline__ void p6_postmix(const Params& p, int gw, int ngw, int lane) {
    const float* Y = (const float*)(p.ws + WS_Y); bf16_t* H = (bf16_t*)(p.ws + WS_H);
    for (int m = gw; m < M; m += ngw) {
        const f32x4* yr = (const f32x4*)(Y + (size_t)m * DM) + lane; const f32x4* xr = (const f32x4*)(p.x + (size_t)m * DM) + lane;
        f32x4 v[8]; float ss = 0.f;
#pragma unroll
        for (int j = 0; j < 8; ++j) { v[j] = yr[64 * j]; ss += (v[j].x * v[j].x + v[j].y * v[j].y) + (v[j].z * v[j].z + v[j].w * v[j].w); }
        const float r1 = 1.0f / sqrtf(wave_sum(ss) * (1.0f / DM) + EPS);
        float s2 = 0.f; f32x4* orow = (f32x4*)(p.out + (size_t)m * DM) + lane;
#pragma unroll
        for (int j = 0; j < 8; ++j) { const f32x4 g = ((const f32x4*)p.post_mix_g)[lane + 64 * j]; v[j] = xr[64 * j] + v[j] * r1 * g; orow[64 * j] = v[j];
            s2 += (v[j].x * v[j].x + v[j].y * v[j].y) + (v[j].z * v[j].z + v[j].w * v[j].w); }
        const float r2 = 1.0f / sqrtf(wave_sum(s2) * (1.0f / DM) + EPS);
        u32x2* o8 = (u32x2*)(H + (size_t)m * DM) + lane;
#pragma unroll
        for (int j = 0; j < 8; ++j) { const f32x4 g = ((const f32x4*)p.pre_mlp_g)[lane + 64 * j]; const f32x4 t = v[j] * r2 * g; o8[64 * j] = (u32x2){pk2(t.x, t.y), pk2(t.z, t.w)}; }
    }
}
__device__ __forceinline__ void p9_final(const Params& p, int gw, int ngw, int lane) {
    const float* MO = (const float*)(p.ws + WS_MO);
    for (int m = gw; m < M; m += ngw) {
        const f32x4* yr = (const f32x4*)(MO + (size_t)m * DM) + lane; f32x4* orow = (f32x4*)(p.out + (size_t)m * DM) + lane;
        f32x4 v[8]; float ss = 0.f;
#pragma unroll
        for (int j = 0; j < 8; ++j) { v[j] = yr[64 * j]; ss += (v[j].x * v[j].x + v[j].y * v[j].y) + (v[j].z * v[j].z + v[j].w * v[j].w); }
        const float r1 = 1.0f / sqrtf(wave_sum(ss) * (1.0f / DM) + EPS);
#pragma unroll
        for (int j = 0; j < 8; ++j) { const f32x4 g = ((const f32x4*)p.post_mlp_g)[lane + 64 * j]; orow[64 * j] = orow[64 * j] + v[j] * r1 * g; }
    }
}

struct EpiProj { bf16_t* O; __device__ __forceinline__ void operator()(int row, int col, const float (&v)[8]) const { *(u32x4*)(O + (size_t)row * INWP + col) = pack8(v); } };
struct EpiKV { bf16_t* KN; bf16_t* V;
    __device__ __forceinline__ void operator()(int row, int col, const float (&v)[8]) const {
        const int head = col >> 8, w = col & 255; bf16_t* dst = (w < NOPE ? KN : V) + (size_t)row * (NH * NOPE) + head * NOPE + (w & 127); *(u32x4*)dst = pack8(v); } };
struct EpiQ { bf16_t* Q; const f32x2* tab;
    __device__ __forceinline__ void operator()(int row, int col, const float (&v)[8]) const {
        const int head = col / QKD, w = col - head * QKD; bf16_t* dst = Q + (size_t)row * NQ + head * QKD;
        if (w < NOPE) { float o[8];
#pragma unroll
            for (int e = 0; e < 8; ++e) o[e] = v[e] * QSCALE;
            *(u32x4*)(dst + w) = pack8(o); }
        else { const int g = (w - NOPE) >> 3, pos = row & (SEQ - 1); const f32x4* tp = (const f32x4*)(tab + pos * 32 + 4 * g); const f32x4 t0 = tp[0], t1 = tp[1];
            const float c[4] = {t0.x, t0.z, t1.x, t1.z}, s[4] = {t0.y, t0.w, t1.y, t1.w}; float o1[4], o2[4];
#pragma unroll
            for (int e = 0; e < 4; ++e) { o1[e] = (v[e] * c[e] - v[4 + e] * s[e]) * QSCALE; o2[e] = (v[4 + e] * c[e] + v[e] * s[e]) * QSCALE; }
            *(u32x2*)(dst + NOPE + 4 * g) = (u32x2){pk2(o1[0], o1[1]), pk2(o1[2], o1[3])};
            *(u32x2*)(dst + NOPE + 32 + 4 * g) = (u32x2){pk2(o2[0], o2[1]), pk2(o2[2], o2[3])}; }
    } };
struct EpiF32 { float* O; int ld;
    __device__ __forceinline__ void operator()(int row, int col, const float (&v)[8]) const {
        f32x4* d = (f32x4*)(O + (size_t)row * ld + col); d[0] = (f32x4){v[0], v[1], v[2], v[3]}; d[1] = (f32x4){v[4], v[5], v[6], v[7]}; } };
struct EpiRelu2 { bf16_t* O;
    __device__ __forceinline__ void operator()(int row, int col, const float (&v)[8]) const { float o[8];
#pragma unroll
        for (int e = 0; e < 8; ++e) { const float r = fmaxf(v[e], 0.f); o[e] = r * r; }
        *(u32x4*)(O + (size_t)row * DFF + col) = pack8(o); } };

template <class Epi>
__global__ __launch_bounds__(256) void ngemm(const bf16_t* __restrict__ A, const bf16_t* __restrict__ Bt, int K, Epi E) {
    __shared__ __attribute__((aligned(16))) float As[32][68];
    __shared__ __attribute__((aligned(16))) float Bs[32][132];
    const int tid = threadIdx.x, ty = tid >> 4, tx = tid & 15, m0 = blockIdx.y * 64, n0 = blockIdx.x * 128;
    float acc[4][8];
#pragma unroll
    for (int i = 0; i < 4; ++i)
#pragma unroll
        for (int j = 0; j < 8; ++j) acc[i][j] = 0.f;
    for (int k0 = 0; k0 < K; k0 += 32) {
        { const int row = tid >> 2, kc = (tid & 3) * 8; float a[8]; unpack8(*(const u32x4*)(A + (size_t)(m0 + row) * K + k0 + kc), a);
#pragma unroll
          for (int e = 0; e < 8; ++e) As[kc + e][row] = a[e]; }
#pragma unroll
        for (int i = 0; i < 2; ++i) { const int idx = tid + 256 * i, row = idx >> 2, kc = (idx & 3) * 8; float b[8]; unpack8(*(const u32x4*)(Bt + (size_t)(n0 + row) * K + k0 + kc), b);
#pragma unroll
          for (int e = 0; e < 8; ++e) Bs[kc + e][row] = b[e]; }
        __syncthreads();
#pragma unroll 8
        for (int k = 0; k < 32; ++k) {
            const f32x4 a4 = *(const f32x4*)&As[k][ty * 4]; const f32x4 b0 = *(const f32x4*)&Bs[k][tx * 8], b1 = *(const f32x4*)&Bs[k][tx * 8 + 4];
#pragma unroll
            for (int i = 0; i < 4; ++i) {
#pragma unroll
                for (int j = 0; j < 4; ++j) { acc[i][j] += a4[i] * b0[j]; acc[i][4 + j] += a4[i] * b1[j]; } }
        }
        __syncthreads();
    }
#pragma unroll
    for (int i = 0; i < 4; ++i) E(m0 + ty * 4 + i, n0 + tx * 8, acc[i]);
}

__global__ __launch_bounds__(256) void nattn(Params p) {
    __shared__ float qs_[4][QKD]; __shared__ float ps_[4][SEQ];
    const int lane = threadIdx.x & 63, w = threadIdx.x >> 6; const int idx = blockIdx.x * 4 + w; const int m = idx >> 3, h = idx & 7, b = m / SEQ, t = m % SEQ;
    const bf16_t* Q = (const bf16_t*)(p.ws + WS_Q); const bf16_t* KN = (const bf16_t*)(p.ws + WS_KN); const bf16_t* V = (const bf16_t*)(p.ws + WS_V);
    const bf16_t* KR = (const bf16_t*)(p.ws + WS_KROPE); bf16_t* MIX = (bf16_t*)(p.ws + WS_MIX);
    float* qs = qs_[w]; float* ps = ps_[w];
    for (int i = 0; i < 3; ++i) qs[lane + 64 * i] = bf1(Q[(size_t)m * NQ + h * QKD + lane + 64 * i]);
    __syncthreads();
    const int nk = ((t >> 6) + 1) * 64; float mx = -1e30f;
    for (int key = lane; key < nk; key += 64) {
        const size_t km = (size_t)b * SEQ + key; float s = 0.f;
        for (int c = 0; c < 16; ++c) { float kv[8]; unpack8(*(const u32x4*)(KN + km * (NH * NOPE) + h * NOPE + 8 * c), kv);
#pragma unroll
            for (int e = 0; e < 8; ++e) s += qs[8 * c + e] * kv[e]; }
        for (int c = 0; c < 8; ++c) { float kv[8]; unpack8(*(const u32x4*)(KR + km * RD + 8 * c), kv);
#pragma unroll
            for (int e = 0; e < 8; ++e) s += qs[NOPE + 8 * c + e] * kv[e]; }
        ps[key] = s; mx = fmaxf(mx, s);
    }
    mx = wave_max(mx); float l = 0.f;
    for (int key = lane; key < nk; key += 64) { const float e = exp2f(ps[key] - mx); ps[key] = e; l += e; }
    l = wave_sum(l);
    __syncthreads();
    float o0 = 0.f, o1 = 0.f;
    for (int key = 0; key < nk; ++key) { const float pk = ps[key]; const unsigned vv = *(const unsigned*)(V + ((size_t)b * SEQ + key) * (NH * VD) + h * VD + 2 * lane); o0 += pk * bflo(vv); o1 += pk * bfhi(vv); }
    o0 /= l; o1 /= l;
    const float ss = wave_sum(o0 * o0 + o1 * o1); const float r = 1.0f / sqrtf(ss * (1.0f / VD) + EPS);
    const float g0 = p.attn_out_g[h * VD + 2 * lane], g1 = p.attn_out_g[h * VD + 2 * lane + 1];
    *(unsigned*)(MIX + (size_t)m * DM + CW + h * VD + 2 * lane) = pk2(o0 * r * g0, o1 * r * g1);
}

namespace pg8 {
#define PG8_LAS __attribute__((address_space(3)))
typedef unsigned short bf16_t;
typedef short bf16x8 __attribute__((ext_vector_type(8)));
typedef float f32x4 __attribute__((ext_vector_type(4)));
typedef unsigned u32x4 __attribute__((ext_vector_type(4)));
constexpr int BM = 256, BK = 64, HALF = 128, HTB = HALF * BK * 2  , STAGE_BYTES = 8 * HTB, NXCD = 8, WGM = 8;

__host__ __device__ __forceinline__ int lds_byte(int r, int c) { const int st = (r >> 4) * 2 + (c >> 5), rr = r & 15, cc = c & 31, ob = rr * 64 + cc * 2; return st * 1024 + (ob ^ (((ob >> 9) & 1) << 5)); }
__host__ __device__ __forceinline__ void stage_rc(int b, int& R, int& C) { const int st = b / 1024, sb = b % 1024, swz = sb ^ (((sb >> 9) & 1) << 5); R = (st >> 1) * 16 + swz / 64; C = (st & 1) * 32 + (swz % 64) / 2; }
__host__ __device__ __forceinline__ int perm32(int rho) { const int n = rho >> 4, i = rho & 15; return 8 * (i >> 2) + 4 * n + (i & 3); }

struct Unit { int pm, pn; };
struct Gemm { const bf16_t* A; const bf16_t* Bt; int M, N, K; };

struct StaticOrder {
    int nM, nN, nwg, G, c;
    __host__ __device__ void init(int M, int N, int G_, int c_) { nM = M / BM; nN = N / BM; nwg = nM * nN; G = G_; c = c_; }
    __host__ __device__ bool next(int i, Unit& u) const {
        const long L = (long)i * G + c; if (L >= nwg) return false;
        int wgid = (int)L; { const int q = nwg / NXCD, r = nwg % NXCD, xcd = wgid % NXCD, off = wgid / NXCD; wgid = (xcd < r ? xcd * (q + 1) : r * (q + 1) + (xcd - r) * q) + off; }
        const int nig = WGM * nN, gid = wgid / nig, fm = gid * WGM, gsz = (nM - fm) < WGM ? (nM - fm) : WGM;
        u.pm = fm + ((wgid % nig) % gsz); u.pn = (wgid % nig) / gsz; return true;
    }
    __device__ __forceinline__ void a_ready(const Unit&) const {}
    __device__ __forceinline__ void done(const Unit&) const {}
};
__device__ __forceinline__ unsigned cvt_pk_bf16(float lo, float hi) { unsigned r; asm volatile("v_cvt_pk_bf16_f32 %0, %1, %2" : "=v"(r) : "v"(lo), "v"(hi)); return r; }
template <class Epi, class Sched, bool ALIGN_EPI = false, bool SP2 = false>
__device__ __forceinline__ void gemm_phase(PG8_LAS unsigned char* lds, const Gemm g, const Sched& S, const Epi& E) {
    const int tid = threadIdx.x, wid = __builtin_amdgcn_readfirstlane(tid >> 6), lane = tid & 63, wr = wid >> 2, wc = wid & 3, fr = lane & 15, fq = lane >> 4;
    const int K = g.K, nt = K / BK;
    unsigned voffA[2], voffB[2];
#pragma unroll
    for (int i = 0; i < 2; ++i) { int R, C; stage_rc(tid * 16 + i * 8192, R, C); const int Rb = Epi::PERM ? ((R & ~31) + perm32(R & 31)) : R;
        voffA[i] = (unsigned)(R * K + C) * 2u; voffB[i] = (unsigned)(Rb * K + C) * 2u; }
    const size_t kstep = (size_t)(BK * 2);
    const size_t hstep = (size_t)HALF * K * 2;
    const size_t tstep = 2 * hstep;
    const unsigned ldsw = (unsigned)wid * 1024u;
    const int aoff = lds_byte(wr * 64 + fr, fq * 8), boff = lds_byte(wc * 32 + fr, fq * 8);
#define PG8_SA(b, h) (((b) * 2 + (h)) * HTB)
#define PG8_SB(b, h) ((4 + (b) * 2 + (h)) * HTB)
#define PG8_STAGE(bufoff, gbase, voff) do { _Pragma("unroll") for (int _i = 0; _i < 2; ++_i) \
        __builtin_amdgcn_global_load_lds((const unsigned*)((const char*)(gbase) + (voff)[_i]), (PG8_LAS unsigned*)(lds + (bufoff) + ldsw + _i * 8192), 16, 0, 0); } while (0)
#define PG8_LDA(dst, b, h) do { _Pragma("unroll") for (int m = 0; m < 4; ++m) _Pragma("unroll") for (int k = 0; k < 2; ++k) dst[m][k] = *(const PG8_LAS bf16x8*)(lds + PG8_SA(b, h) + aoff + m * 2048 + k * 1024); } while (0)
#define PG8_LDB(dst, b, h) do { _Pragma("unroll") for (int n = 0; n < 2; ++n) _Pragma("unroll") for (int k = 0; k < 2; ++k) dst[n][k] = *(const PG8_LAS bf16x8*)(lds + PG8_SB(b, h) + boff + n * 2048 + k * 1024); } while (0)
#define PG8_MMA(ai, bj, At, Bt) do { __builtin_amdgcn_s_setprio(1); _Pragma("unroll") for (int m = 0; m < 4; ++m) _Pragma("unroll") for (int n = 0; n < 2; ++n) _Pragma("unroll") for (int k = 0; k < 2; ++k) \
        acc[ai][bj][m][n] = __builtin_amdgcn_mfma_f32_16x16x32_bf16(Bt[n][k], At[m][k], acc[ai][bj][m][n], 0, 0, 0); __builtin_amdgcn_s_setprio(0); } while (0)
#define PG8_WAIT_V(n) asm volatile("s_waitcnt vmcnt(" #n ")" ::: "memory")
#define PG8_WAIT_L(n) asm volatile("s_waitcnt lgkmcnt(" #n ")" ::: "memory")
#define PG8_BAR __builtin_amdgcn_s_barrier()
#define PG8_SCHED __builtin_amdgcn_sched_barrier(0)
    Unit cur, nxt; int ui = 0;
    if (!S.next(0, cur)) return;
    f32x4 acc[2][2][4][2];
#pragma unroll
    for (int a = 0; a < 2; ++a)
#pragma unroll
        for (int b = 0; b < 2; ++b)
#pragma unroll
            for (int m = 0; m < 4; ++m)
#pragma unroll
                for (int n = 0; n < 2; ++n) acc[a][b][m][n] = (f32x4){0.f, 0.f, 0.f, 0.f};
    bf16x8 At[4][2], B0[2][2], B1[2][2];
    const char* cA = (const char*)g.A + (size_t)cur.pm * tstep; const char* cB = (const char*)g.Bt + (size_t)cur.pn * tstep;
    S.a_ready(cur);
    if constexpr (SP2) {
        PG8_STAGE(PG8_SB(0, 0), cB, voffB); PG8_STAGE(PG8_SB(0, 1), cB + hstep, voffB); PG8_STAGE(PG8_SA(0, 0), cA, voffA); PG8_STAGE(PG8_SA(0, 1), cA + hstep, voffA);
        if (wr == 1) PG8_BAR;
        PG8_WAIT_V(2); PG8_BAR;
        PG8_STAGE(PG8_SB(1, 0), cB + kstep, voffB); PG8_STAGE(PG8_SA(1, 0), cA + kstep, voffA); PG8_STAGE(PG8_SB(1, 1), cB + hstep + kstep, voffB);
        PG8_WAIT_V(6); PG8_BAR;
    } else {
        PG8_STAGE(PG8_SB(0, 0), cB, voffB); PG8_STAGE(PG8_SA(0, 0), cA, voffA); PG8_STAGE(PG8_SB(0, 1), cB + hstep, voffB); PG8_STAGE(PG8_SA(0, 1), cA + hstep, voffA);
        if (wr == 1) PG8_BAR;
        PG8_WAIT_V(4); PG8_BAR;
        PG8_STAGE(PG8_SB(1, 0), cB + kstep, voffB); PG8_STAGE(PG8_SA(1, 0), cA + kstep, voffA); PG8_STAGE(PG8_SB(1, 1), cB + hstep + kstep, voffB);
        PG8_WAIT_V(6); PG8_BAR;
    }
    for (;;) {
        const bool has_next = S.next(ui + 1, nxt);
        const char* nA = has_next ? (const char*)g.A + (size_t)nxt.pm * tstep : cA; const char* nB = has_next ? (const char*)g.Bt + (size_t)nxt.pn * tstep : cB;
        for (int t = 0; t < nt; t += 2) {
            const bool last = (t == nt - 2);
            const char* a1 = cA + (size_t)(t + 1) * kstep;
            const char* a2 = last ? nA : cA + (size_t)(t + 2) * kstep; const char* b2 = last ? nB : cB + (size_t)(t + 2) * kstep;
            const char* a3 = a2 + kstep; const char* b3 = b2 + kstep;
            if (last && has_next) S.a_ready(nxt);
            if constexpr (SP2) {
            PG8_LDB(B0, 0, 0); PG8_LDB(B1, 0, 1); PG8_SCHED; PG8_LDA(At, 0, 0); PG8_STAGE(PG8_SA(1, 1), a1 + hstep, voffA);
            PG8_WAIT_V(8); PG8_WAIT_L(0); PG8_BAR; PG8_MMA(0, 0, At, B0); PG8_MMA(0, 1, At, B1); PG8_BAR; PG8_SCHED;
            PG8_LDA(At, 0, 1); PG8_STAGE(PG8_SB(0, 0), b2, voffB); PG8_STAGE(PG8_SB(0, 1), b2 + hstep, voffB); PG8_STAGE(PG8_SA(0, 0), a2, voffA);
            PG8_WAIT_V(8); PG8_WAIT_L(0); PG8_BAR; PG8_MMA(1, 0, At, B0); PG8_MMA(1, 1, At, B1); PG8_BAR; PG8_SCHED;
            PG8_LDB(B0, 1, 0); PG8_LDB(B1, 1, 1); PG8_SCHED; PG8_LDA(At, 1, 0); PG8_STAGE(PG8_SA(0, 1), a2 + hstep, voffA);
            PG8_WAIT_V(8); PG8_WAIT_L(0); PG8_BAR; PG8_MMA(0, 0, At, B0); PG8_MMA(0, 1, At, B1); PG8_BAR; PG8_SCHED;
            PG8_LDA(At, 1, 1); PG8_STAGE(PG8_SB(1, 0), b3, voffB); PG8_STAGE(PG8_SB(1, 1), b3 + hstep, voffB); PG8_STAGE(PG8_SA(1, 0), a3, voffA);
            PG8_WAIT_V(8); PG8_WAIT_L(0); PG8_BAR; PG8_MMA(1, 0, At, B0); PG8_MMA(1, 1, At, B1); PG8_BAR; PG8_SCHED;
            } else {
            PG8_LDB(B0, 0, 0); PG8_SCHED; PG8_LDA(At, 0, 0); PG8_STAGE(PG8_SA(1, 1), a1 + hstep, voffA);
            PG8_WAIT_L(8); PG8_BAR; PG8_WAIT_L(0); PG8_MMA(0, 0, At, B0); PG8_BAR; PG8_SCHED;
            PG8_LDB(B1, 0, 1); PG8_STAGE(PG8_SB(0, 0), b2, voffB);
            PG8_BAR; PG8_WAIT_L(0); PG8_MMA(0, 1, At, B1); PG8_BAR;
            PG8_LDA(At, 0, 1); PG8_STAGE(PG8_SA(0, 0), a2, voffA);
            PG8_BAR; PG8_WAIT_L(0); PG8_MMA(1, 0, At, B0); PG8_BAR; PG8_SCHED;
            PG8_STAGE(PG8_SB(0, 1), b2 + hstep, voffB);
            PG8_WAIT_V(6); PG8_BAR; PG8_MMA(1, 1, At, B1); PG8_BAR;
            PG8_LDB(B0, 1, 0); PG8_SCHED; PG8_LDA(At, 1, 0); PG8_STAGE(PG8_SA(0, 1), a2 + hstep, voffA);
            PG8_WAIT_L(8); PG8_BAR; PG8_WAIT_L(0); PG8_MMA(0, 0, At, B0); PG8_BAR; PG8_SCHED;
            PG8_LDB(B1, 1, 1); PG8_STAGE(PG8_SB(1, 0), b3, voffB);
            PG8_BAR; PG8_WAIT_L(0); PG8_MMA(0, 1, At, B1); PG8_BAR;
            PG8_LDA(At, 1, 1); PG8_STAGE(PG8_SA(1, 0), a3, voffA);
            PG8_BAR; PG8_WAIT_L(0); PG8_MMA(1, 0, At, B0); PG8_BAR; PG8_SCHED;
            PG8_STAGE(PG8_SB(1, 1), b3 + hstep, voffB);
            PG8_WAIT_V(6); PG8_BAR; PG8_MMA(1, 1, At, B1); PG8_BAR;
            }
        }
        if constexpr (ALIGN_EPI) { if (wr == 0) PG8_BAR; }
        if constexpr (!Epi::AFTER_DRAIN) { E(acc, cur, wr, wc, fr, fq); S.done(cur); }
        if (!has_next) break;
#pragma unroll
        for (int a = 0; a < 2; ++a)
#pragma unroll
            for (int b = 0; b < 2; ++b)
#pragma unroll
                for (int m = 0; m < 4; ++m)
#pragma unroll
                    for (int n = 0; n < 2; ++n) acc[a][b][m][n] = (f32x4){0.f, 0.f, 0.f, 0.f};
        cur = nxt; cA = nA; cB = nB; ++ui;
        if constexpr (ALIGN_EPI) { if (wr == 1) PG8_BAR; }
    }
    PG8_WAIT_V(0);
    if constexpr (!ALIGN_EPI) { if (wr == 0) PG8_BAR; }
    PG8_BAR;
    if constexpr (Epi::AFTER_DRAIN) { E.fused(acc, cur, wr, wc, fr, fq, lds, wid, lane); S.done(cur); }
#undef PG8_SA
#undef PG8_SB
#undef PG8_STAGE
#undef PG8_LDA
#undef PG8_LDB
#undef PG8_MMA
#undef PG8_WAIT_V
#undef PG8_WAIT_L
#undef PG8_BAR
#undef PG8_SCHED
}
}
__device__ __forceinline__ unsigned long long rt() { return __builtin_amdgcn_s_memrealtime(); }
#define XB_TMO      128
#define XB_XCNT(j)  (256  + 64 * (j))
#define XB_XSUB(j)  (1280 + 64 * (j))
#define XB_XGEN(j)  (2304 + 64 * (j))
#define XB_TOP      3328
#define XB_TOPGEN   3392
#define XCD_BAR_WORDS 3456
#define XB_SPIN_CAP (1u << 18)

__device__ __forceinline__ unsigned xb_ld(unsigned* p)              { return __hip_atomic_load(p, __ATOMIC_RELAXED, __HIP_MEMORY_SCOPE_AGENT); }
__device__ __forceinline__ unsigned xb_add(unsigned* p, unsigned v) { return __hip_atomic_fetch_add(p, v, __ATOMIC_RELAXED, __HIP_MEMORY_SCOPE_AGENT); }
__device__ __forceinline__ unsigned xb_xcc_id() { return (unsigned)__builtin_amdgcn_s_getreg((3 << 11) | 20) & 0xFu; }
#define XB_SPIN(cond, bar) do { unsigned _sp = 0; while (cond) { __builtin_amdgcn_s_sleep(1); \
    if ((++_sp & 255u) == 0u) { if (xb_ld(&(bar)[XB_TMO])) break; if (_sp > XB_SPIN_CAP) { atomicAdd(&(bar)[XB_TMO], 1u); break; } } } } while (0)

struct XcdBarrier {
    unsigned* bar; unsigned x;
    volatile LAS unsigned* st;
};

__device__ __forceinline__ XcdBarrier xcd_barrier_post(unsigned* bar, volatile LAS unsigned* st) {
    XcdBarrier b; b.bar = bar; b.x = xb_xcc_id(); b.st = st;
    if (threadIdx.x == 0) (void)xb_add(&bar[XB_XCNT(b.x)], 1u);
    return b;
}
__device__ __forceinline__ void xcd_barrier_complete(unsigned* bar, unsigned x, unsigned& nloc, unsigned& nx) {
    const unsigned G = gridDim.x * gridDim.y * gridDim.z;
    unsigned sum, cnt, mine, sp = 0u;
    for (;;) {
        sum = 0u; cnt = 0u; mine = 0u;
#pragma unroll
        for (unsigned j = 0; j < 16; ++j) { const unsigned c = xb_ld(&bar[XB_XCNT(j)]); sum += c; cnt += (c > 0u) ? 1u : 0u; mine = (j == x) ? c : mine; }
        if (sum == G) break;
        __builtin_amdgcn_s_sleep(1);
        if ((++sp & 255u) == 0u) { if (xb_ld(&bar[XB_TMO])) break; if (sp > XB_SPIN_CAP) { atomicAdd(&bar[XB_TMO], 1u); break; } }
    }
    nloc = mine > 0u ? mine : 1u; nx = cnt > 0u ? cnt : 1u;
}

__device__ __forceinline__ void xcd_barrier(const XcdBarrier& b) {
    asm volatile("s_waitcnt vmcnt(0)" ::: "memory");
    __syncthreads();
    if (threadIdx.x == 0) {
        unsigned* bar = b.bar;
        __builtin_amdgcn_s_waitcnt(0);
        unsigned nloc = b.st[0], nx = b.st[1];
        if (nloc == 0u) { xcd_barrier_complete(bar, b.x, nloc, nx); b.st[0] = nloc; b.st[1] = nx; }
        const unsigned old = xb_add(&bar[XB_XSUB(b.x)], 1u);
        const unsigned gen = old / nloc;
        if (old + 1u == (gen + 1u) * nloc) {
            __builtin_amdgcn_fence(__ATOMIC_RELEASE, "agent");
            asm volatile("s_waitcnt vmcnt(0)" ::: "memory");
            const unsigned og = xb_add(&bar[XB_TOP], 1u);
            const unsigned tg = og / nx;
            if (og + 1u == (tg + 1u) * nx) xb_add(&bar[XB_TOPGEN], 1u);
            else XB_SPIN(xb_ld(&bar[XB_TOPGEN]) == tg, bar);
            __builtin_amdgcn_fence(__ATOMIC_ACQUIRE, "agent");
            xb_add(&bar[XB_XGEN(b.x)], 1u);
            asm volatile("s_waitcnt vmcnt(0)" ::: "memory");
        } else {
            XB_SPIN(xb_ld(&bar[XB_XGEN(b.x)]) == gen, bar);
            __builtin_amdgcn_fence(__ATOMIC_ACQUIRE, "agent");
            asm volatile("s_waitcnt vmcnt(0)" ::: "memory");
        }
    }
    __syncthreads();
}
namespace att {
using bf16x8 = __attribute__((ext_vector_type(8))) short;
using s16x4 = __attribute__((ext_vector_type(4))) short;
using f32x16 = __attribute__((ext_vector_type(16))) float;
constexpr int NW = 8, QBLK = 32, KVBLK = 64;
constexpr int SHM_V = KVBLK * VD * 2, SHM_KN = KVBLK * 272, SHM_KR = KVBLK * 144, SHM_QR = 32 * 144;
constexpr int OFF_V = 0, OFF_KN = 2 * SHM_V, OFF_KR = OFF_KN + 2 * SHM_KN, OFF_WS = OFF_KR + 2 * SHM_KR, OFF_QR = OFF_WS + NW * 64 * 4, LDS_BYTES = OFF_QR + NW * SHM_QR;
static_assert(LDS_BYTES <= 131072 && OFF_KR >= 65536, "attention LDS map");
constexpr float THR2 = 8.0f;
#define KSWZ(row, colB) ((row) * 272 + (colB))
#define RSWZ(row, colB) ((row) * 144 + (colB))
#define SBAR() __builtin_amdgcn_sched_barrier(0)
__device__ __forceinline__ int crow(int r, int hi) { return (r & 3) + 8 * (r >> 2) + 4 * hi; }
__device__ __forceinline__ unsigned cvtpk(float lo, float hi) { unsigned r; asm volatile("v_cvt_pk_bf16_f32 %0, %1, %2" : "=v"(r) : "v"(lo), "v"(hi)); return r; }

__device__ __forceinline__ void partialSM(f32x16& p0, f32x16& p1, float& m_reg, float& mn, float& alpha) {
  float pmax = p0[0];
#pragma unroll
  for (int r = 1; r < 16; ++r) pmax = fmaxf(pmax, p0[r]);
#pragma unroll
  for (int r = 0; r < 16; ++r) pmax = fmaxf(pmax, p1[r]);
  { auto rr = __builtin_amdgcn_permlane32_swap(__float_as_uint(pmax), __float_as_uint(pmax), false, false);
    pmax = fmaxf(__uint_as_float(rr[0]), __uint_as_float(rr[1])); }
  if (__builtin_expect(__all(pmax - m_reg <= THR2), 1)) { mn = m_reg; alpha = 1.f; }
  else { mn = fmaxf(m_reg, pmax); alpha = __builtin_amdgcn_exp2f(m_reg - mn); m_reg = mn; }
#pragma unroll
  for (int r = 0; r < 16; ++r) p0[r] = p0[r] - mn;
#pragma unroll
  for (int r = 0; r < 16; ++r) p1[r] = p1[r] - mn;
#pragma unroll
  for (int r = 0; r < 16; ++r) p0[r] = __builtin_amdgcn_exp2f(p0[r]);
}
__device__ __forceinline__ void finishSM(f32x16& p0, f32x16& p1, float alpha, float& l_reg, bf16x8& pa0, bf16x8& pa1, bf16x8& pa2, bf16x8& pa3) {
#pragma unroll
  for (int r = 0; r < 16; ++r) p1[r] = __builtin_amdgcn_exp2f(p1[r]);
  float ps = 0;
#pragma unroll
  for (int r = 0; r < 16; ++r) ps += p0[r];
#pragma unroll
  for (int r = 0; r < 16; ++r) ps += p1[r];
  { auto rr = __builtin_amdgcn_permlane32_swap(__float_as_uint(ps), __float_as_uint(ps), false, false);
    ps = __uint_as_float(rr[0]) + __uint_as_float(rr[1]); }
  l_reg = l_reg * alpha + ps;
#define PK4(P, BASE, OUT) do { unsigned a0 = cvtpk(P[BASE + 0], P[BASE + 1]), a1 = cvtpk(P[BASE + 2], P[BASE + 3]);   \
    unsigned b0 = cvtpk(P[BASE + 4], P[BASE + 5]), b1 = cvtpk(P[BASE + 6], P[BASE + 7]);                              \
    auto r0 = __builtin_amdgcn_permlane32_swap(a0, b0, false, false); auto r1 = __builtin_amdgcn_permlane32_swap(a1, b1, false, false); \
    u32x4 w = {r0[0], r1[0], r0[1], r1[1]}; OUT = *reinterpret_cast<bf16x8*>(&w); } while (0)
  PK4(p0, 0, pa0); PK4(p0, 8, pa1); PK4(p1, 0, pa2); PK4(p1, 8, pa3);
#undef PK4
}
__device__ __forceinline__ void qkt(f32x16& p0, f32x16& p1, const char* Kn, const char* Kr, const bf16x8* qr, const char* Qr, int r32, int hi) {
  p0 = f32x16{}; p1 = f32x16{};
#pragma unroll
  for (int d0 = 0; d0 < 8; ++d0) { const int cb = (d0 * 16 + hi * 8) * 2;
    const bf16x8 b0 = *reinterpret_cast<const bf16x8*>(Kn + KSWZ(r32, cb));
    const bf16x8 b1 = *reinterpret_cast<const bf16x8*>(Kn + KSWZ(32 + r32, cb));
    p0 = __builtin_amdgcn_mfma_f32_32x32x16_bf16(b0, qr[d0], p0, 0, 0, 0);
    p1 = __builtin_amdgcn_mfma_f32_32x32x16_bf16(b1, qr[d0], p1, 0, 0, 0); }
#pragma unroll
  for (int d0 = 0; d0 < 4; ++d0) { const int cb = (d0 * 16 + hi * 8) * 2;
    const bf16x8 b0 = *reinterpret_cast<const bf16x8*>(Kr + RSWZ(r32, cb));
    const bf16x8 b1 = *reinterpret_cast<const bf16x8*>(Kr + RSWZ(32 + r32, cb));
    const bf16x8 qf = *reinterpret_cast<const bf16x8*>(Qr + RSWZ(r32, cb));
    p0 = __builtin_amdgcn_mfma_f32_32x32x16_bf16(b0, qf, p0, 0, 0, 0);
    p1 = __builtin_amdgcn_mfma_f32_32x32x16_bf16(b1, qf, p1, 0, 0, 0); }
}
__device__ __forceinline__ int v_st(int k, int c) { const int kk = (k & ~0xC) | ((k & 4) << 1) | ((k & 8) >> 1); return ((kk >> 3) * 4 + (c >> 5)) * 512 + ((kk & 7) * 32 + (c & 31)) * 2; }
__device__ __forceinline__ int v_rd_base(int lane) { return ((lane & 3) << 3) | (((lane >> 2) & 3) << 6) | (((lane >> 4) & 1) << 5) | (((lane >> 5) & 1) << 8); }
constexpr int v_rd_off(int d0, int ks, int half) { return d0 * 512 + ks * 4096 + half * 2048; }
template <int OFF> __device__ __forceinline__ s16x4 tr_read(int vb) {
  s16x4 r; asm volatile("ds_read_b64_tr_b16 %0, %1 offset:%2" : "=&v"(r) : "v"(vb), "i"(OFF) : "memory"); return r;
}
template <int D0> __device__ __forceinline__ void pv_one(f32x16& od, int vb, bf16x8 pa0, bf16x8 pa1, bf16x8 pa2, bf16x8 pa3) {
  const s16x4 l0 = tr_read<v_rd_off(D0, 0, 0)>(vb), h0 = tr_read<v_rd_off(D0, 0, 1)>(vb), l1 = tr_read<v_rd_off(D0, 1, 0)>(vb), h1 = tr_read<v_rd_off(D0, 1, 1)>(vb);
  const s16x4 l2 = tr_read<v_rd_off(D0, 2, 0)>(vb), h2 = tr_read<v_rd_off(D0, 2, 1)>(vb), l3 = tr_read<v_rd_off(D0, 3, 0)>(vb), h3 = tr_read<v_rd_off(D0, 3, 1)>(vb);
  asm volatile("s_waitcnt lgkmcnt(0)" ::: "memory"); SBAR();
#define PK(L, H) (bf16x8){L[0], L[1], L[2], L[3], H[0], H[1], H[2], H[3]}
  od = __builtin_amdgcn_mfma_f32_32x32x16_bf16(pa0, PK(l0, h0), od, 0, 0, 0);
  od = __builtin_amdgcn_mfma_f32_32x32x16_bf16(pa1, PK(l1, h1), od, 0, 0, 0);
  od = __builtin_amdgcn_mfma_f32_32x32x16_bf16(pa2, PK(l2, h2), od, 0, 0, 0);
  od = __builtin_amdgcn_mfma_f32_32x32x16_bf16(pa3, PK(l3, h3), od, 0, 0, 0);
#undef PK
}
__device__ __forceinline__ void pv_d0(f32x16* o, int vb, bf16x8 pa0, bf16x8 pa1, bf16x8 pa2, bf16x8 pa3) {
  pv_one<0>(o[0], vb, pa0, pa1, pa2, pa3); pv_one<1>(o[1], vb, pa0, pa1, pa2, pa3); pv_one<2>(o[2], vb, pa0, pa1, pa2, pa3); pv_one<3>(o[3], vb, pa0, pa1, pa2, pa3);
}

__device__ __forceinline__ void attn_unit(const Params& p, int b, int h, int qb, char* lds) {
  const int tid = threadIdx.x, wid = __builtin_amdgcn_readfirstlane(tid >> 6), lane = tid & 63, r32 = lane & 31, hi = lane >> 5;
  const bf16_t* Qg = (const bf16_t*)(p.ws + WS_Q); const bf16_t* KNg = (const bf16_t*)(p.ws + WS_KN); const bf16_t* Vg = (const bf16_t*)(p.ws + WS_V);
  const bf16_t* KRg = (const bf16_t*)(p.ws + WS_KROPE); bf16_t* MIX = (bf16_t*)(p.ws + WS_MIX);
  char* V_lds = lds + OFF_V; char* Kn_lds = lds + OFF_KN; char* Kr_lds = lds + OFF_KR;
  float* ws = (float*)(lds + OFF_WS) + wid * 64; float* li_l = ws; float* al_l = ws + 32;
  const long rowbase = (long)b * SEQ; const int q0 = qb * (QBLK * NW);
  const int NT = 4 * qb + 4, nvis = 4 * qb + (wid >> 1) + 1;
  float m_reg = -1e30f, l_reg = 0; f32x16 o[4] = {}; bf16x8 qr[8];
  const bf16_t* Qw = Qg + (rowbase + q0 + wid * QBLK + r32) * NQ + h * QKD + hi * 8;
#pragma unroll
  for (int d0 = 0; d0 < 8; ++d0) qr[d0] = *reinterpret_cast<const bf16x8*>(Qw + d0 * 16);
  char* Qr_lds = lds + OFF_QR + wid * SHM_QR;
#pragma unroll
  for (int d0 = 0; d0 < 4; ++d0) *(bf16x8*)(Qr_lds + RSWZ(r32, (d0 * 16 + hi * 8) * 2)) = *reinterpret_cast<const bf16x8*>(Qw + NOPE + d0 * 16);
  const int sr = tid >> 4, sc = (tid & 15) * 8, vst0 = v_st(sr, sc), vst1 = v_st(32 + sr, sc);
  const int krow = tid >> 3, kcol = (tid & 7) * 8;
  const bf16_t* Vh = Vg + rowbase * (NH * VD) + h * VD; const bf16_t* Kh = KNg + rowbase * (NH * NOPE) + h * NOPE; const bf16_t* Rh = KRg + rowbase * RD;
  const int vb0 = (int)(uintptr_t)V_lds + v_rd_base(lane);
  bf16x8 vs0, vs1, ks0, ks1, rs0;
#define SLOAD(k0) do { vs0 = *reinterpret_cast<const bf16x8*>(&Vh[(long)((k0) + sr) * (NH * VD) + sc]); vs1 = *reinterpret_cast<const bf16x8*>(&Vh[(long)((k0) + 32 + sr) * (NH * VD) + sc]); \
    ks0 = *reinterpret_cast<const bf16x8*>(&Kh[(long)((k0) + sr) * (NH * NOPE) + sc]); ks1 = *reinterpret_cast<const bf16x8*>(&Kh[(long)((k0) + 32 + sr) * (NH * NOPE) + sc]); \
    rs0 = *reinterpret_cast<const bf16x8*>(&Rh[(long)((k0) + krow) * RD + kcol]); } while (0)
#define SWRITE(bb) do { *(bf16x8*)(V_lds + (bb) * SHM_V + vst0) = vs0; *(bf16x8*)(V_lds + (bb) * SHM_V + vst1) = vs1; \
    *(bf16x8*)(Kn_lds + (bb) * SHM_KN + KSWZ(sr, sc * 2)) = ks0; *(bf16x8*)(Kn_lds + (bb) * SHM_KN + KSWZ(32 + sr, sc * 2)) = ks1; \
    *(bf16x8*)(Kr_lds + (bb) * SHM_KR + RSWZ(krow, kcol * 2)) = rs0; } while (0)
#define SWAIT() asm volatile("s_waitcnt vmcnt(0)" ::: "memory")
#define RESC(a) do { if (__any((a) < 1.f)) { if (hi == 0) al_l[r32] = (a); asm volatile("s_waitcnt lgkmcnt(0)" ::: "memory"); \
    _Pragma("unroll") for (int d = 0; d < 4; ++d) _Pragma("unroll") for (int r = 0; r < 16; ++r) o[d][r] *= al_l[crow(r, hi)]; } } while (0)
#define QK(P0, P1, bb, t) do { if ((t) < nvis) qkt(P0, P1, Kn_lds + (bb) * SHM_KN, Kr_lds + (bb) * SHM_KR, qr, Qr_lds, r32, hi); \
    else { _Pragma("unroll") for (int r = 0; r < 16; ++r) { P0[r] = -1e30f; P1[r] = -1e30f; } } } while (0)
#define PV(bb, t) do { if ((t) < nvis) pv_d0(o, vb0 + (bb) * SHM_V, pa0, pa1, pa2, pa3); } while (0)
  f32x16 pA0, pA1, pB0, pB1; float mnA, mnB, alA, alB; bf16x8 pa0, pa1, pa2, pa3;
  SLOAD(0); SWAIT(); SWRITE(0); __syncthreads();
  QK(pA0, pA1, 0, 0); partialSM(pA0, pA1, m_reg, mnA, alA);
  SLOAD(KVBLK);
  SWAIT(); SWRITE(1); __syncthreads();
  for (int j = 1; j + 1 < NT; j += 2) {
    SBAR(); QK(pB0, pB1, 1, j);
    finishSM(pA0, pA1, alA, l_reg, pa0, pa1, pa2, pa3); SBAR();
    SLOAD((j + 1) * KVBLK); SBAR();
    PV(0, j - 1); partialSM(pB0, pB1, m_reg, mnB, alB);
    __syncthreads(); SWAIT(); SWRITE(0);
    RESC(alB); __syncthreads();
    SBAR(); QK(pA0, pA1, 0, j + 1);
    finishSM(pB0, pB1, alB, l_reg, pa0, pa1, pa2, pa3); SBAR();
    SLOAD((j + 2) * KVBLK); SBAR();
    PV(1, j); partialSM(pA0, pA1, m_reg, mnA, alA);
    __syncthreads(); SWAIT(); SWRITE(1);
    RESC(alA); __syncthreads();
  }
  SBAR(); QK(pB0, pB1, 1, NT - 1);
  finishSM(pA0, pA1, alA, l_reg, pa0, pa1, pa2, pa3); SBAR();
  PV(0, NT - 2); partialSM(pB0, pB1, m_reg, mnB, alB);
  __syncthreads(); RESC(alB);
  finishSM(pB0, pB1, alB, l_reg, pa0, pa1, pa2, pa3); SBAR();
  PV(1, NT - 1);
  int le = lane; asm volatile("" : "+v"(le));
  const int r32e = le & 31, hie = le >> 5;
  if (hie == 0) li_l[r32e] = l_reg; asm volatile("s_waitcnt lgkmcnt(0)" ::: "memory");
  float gsc[4];
#pragma unroll
  for (int d0 = 0; d0 < 4; ++d0) gsc[d0] = p.attn_out_g[h * VD + d0 * 32 + r32e];
  const float* lrow = li_l + 4 * hie;
#pragma unroll
  for (int r = 0; r < 16; ++r) {
    const float rl = __builtin_amdgcn_rcpf(lrow[(r & 3) + 8 * (r >> 2)]); float s = 0.f;
#pragma unroll
    for (int d0 = 0; d0 < 4; ++d0) { o[d0][r] *= rl; s += o[d0][r] * o[d0][r]; }
    s += __shfl_xor(s, 1); s += __shfl_xor(s, 2); s += __shfl_xor(s, 4); s += __shfl_xor(s, 8); s += __shfl_xor(s, 16);
    const float rn = 1.0f / sqrtf(s * (1.0f / VD) + EPS);
#pragma unroll
    for (int d0 = 0; d0 < 4; ++d0) o[d0][r] *= rn * gsc[d0];
  }
  __syncthreads();
  { bf16_t* stg = (bf16_t*)(lds + wid * 8192);
    bf16_t* sw = stg + (4 * hie) * 128 + r32e;
#pragma unroll
    for (int r = 0; r < 16; ++r) {
#pragma unroll
      for (int d0 = 0; d0 < 4; ++d0) sw[((r & 3) + 8 * (r >> 2)) * 128 + d0 * 32] = (bf16_t)f2bf(o[d0][r]); }
    asm volatile("s_waitcnt lgkmcnt(0)" ::: "memory");
    const int lr = le >> 4, ch = le & 15;
    const bf16_t* sr_ = stg + lr * 128 + ch * 8;
    bf16_t* Ow = MIX + (rowbase + q0 + wid * QBLK + lr) * DM + CW + h * VD + ch * 8;
#pragma unroll
    for (int i = 0; i < 8; ++i) { const u32x4 v = *(const u32x4*)(sr_ + i * 4 * 128); *(u32x4*)(Ow + (long)i * 4 * DM) = v; } }
  __syncthreads();
#undef SLOAD
#undef SWRITE
#undef SWAIT
#undef RESC
#undef QK
#undef PV
}
#undef KSWZ
#undef RSWZ
#undef SBAR
}
#ifndef MK_PER_PHASE
#define MK_PER_PHASE 0
#endif
#ifndef MK_NAIVE_ATTN
#define MK_NAIVE_ATTN 0
#endif
constexpr int NWAVES = 8, NPHASE = 10;
constexpr int RING_BYTES = 131072, LDSCTL_OFF = RING_BYTES, MISC_OFF = LDSCTL_OFF + 320, LDS_TOTAL = 147456;
constexpr int CW_TMO = 0, CW_BAR = 4096;
constexpr size_t CTL_ZERO_BYTES = 65536;
typedef GAS unsigned gu32;
#define RLX_AGENT __ATOMIC_RELAXED, __HIP_MEMORY_SCOPE_AGENT

template <class F> struct EpiAdapt {
    static constexpr bool PERM = true, AFTER_DRAIN = false; F f;
    __device__ __forceinline__ void operator()(const pg8::f32x4 (&acc)[2][2][4][2], const pg8::Unit& u, int wr, int wc, int fr, int fq) const {
#pragma unroll
        for (int ai = 0; ai < 2; ++ai)
#pragma unroll
            for (int m = 0; m < 4; ++m) { const int row = u.pm * 256 + ai * 128 + wr * 64 + m * 16 + fr;
#pragma unroll
                for (int bj = 0; bj < 2; ++bj) { const int col = u.pn * 256 + bj * 128 + wc * 32 + 8 * fq;
                    const pg8::f32x4 a = acc[ai][bj][m][0], b = acc[ai][bj][m][1]; const float v[8] = {a[0], a[1], a[2], a[3], b[0], b[1], b[2], b[3]};
                    f(row, col, v); } }
    }
};
template <class F> __device__ __forceinline__ void run_gemm(LAS unsigned char* lds, const bf16_t* A, const bf16_t* Bt, int N, int K, int G, int c, const F& f) {
    pg8::Gemm g{A, Bt, M, N, K}; pg8::StaticOrder S; S.init(M, N, G, c); EpiAdapt<F> E{f};
    pg8::gemm_phase<EpiAdapt<F>, pg8::StaticOrder, true, true>(lds, g, S, E);
}

struct Args { Params p; int ph_lo, ph_hi, li, pad; };
__global__ void __launch_bounds__(NWAVES * 64, 2) mk_fwd(Args args) {
    extern __shared__ __attribute__((aligned(16))) unsigned char lds[];
    const Params& p = args.p;
    LAS unsigned char* L = (LAS unsigned char*)lds;
    volatile LAS unsigned* MISC = (volatile LAS unsigned*)(L + MISC_OFF);
    const int tid = threadIdx.x, lane = tid & 63, wave = __builtin_amdgcn_readfirstlane(tid >> 6);
    const int G = gridDim.x, bx = blockIdx.x, vcu = (G % 8 == 0) ? (bx % 8) * (G / 8) + bx / 8 : bx;
    const int gw = vcu * NWAVES + wave, ngw = G * NWAVES;
    for (int u = tid; u < (LDS_TOTAL - LDSCTL_OFF) / 4; u += NWAVES * 64) ((LAS unsigned*)(L + LDSCTL_OFF))[u] = 0u;
    __syncthreads();
    unsigned* ctl = (unsigned*)(p.ws + WS_CTL);
    XcdBarrier bar; bar.bar = ctl + CW_BAR; bar.x = 0; bar.st = nullptr;
    const int lo = args.ph_lo, hi = args.ph_hi;
    if (hi - lo > 1) bar = xcd_barrier_post(ctl + CW_BAR, MISC + 8);
#define IN(k) (lo <= (k) && (k) < hi)
#define SEAM(k) do { if (IN(k) && IN((k) + 1)) xcd_barrier(bar); } while (0)
    unsigned char* ws = p.ws;
    if (IN(0)) { p0_weights(p, (lds_float*)(L + wave * 16384), gw, ngw, lane); p0_table(p, bx * (NWAVES * 64) + tid, G * NWAVES * 64);
                 rms_rows_2048(p.x, p.pre_mix_g, (bf16_t*)(ws + WS_H), gw, ngw, lane); }
    SEAM(0);
    if (IN(1)) run_gemm(L, (const bf16_t*)(ws + WS_H), (const bf16_t*)(ws + WS_WIN), INWP, DM, G, bx, EpiProj{(bf16_t*)(ws + WS_PROJ)});
    SEAM(1);
    if (IN(2)) p2_mixprep(p, gw, ngw, lane);
    SEAM(2);
    if (IN(3)) { run_gemm(L, (const bf16_t*)(ws + WS_CKVN), (const bf16_t*)(ws + WS_WUKV), NKV, KVR, G, bx, EpiKV{(bf16_t*)(ws + WS_KN), (bf16_t*)(ws + WS_V)});
                 run_gemm(L, (const bf16_t*)(ws + WS_CQN), (const bf16_t*)(ws + WS_WUQ), NQ, QR, G, bx, EpiQ{(bf16_t*)(ws + WS_Q), (const f32x2*)(ws + WS_TAB)}); }
    SEAM(3);
    if (IN(4)) { for (int u = vcu; u < NH * 4 * 8; u += G) { const int bh = u >> 3, qb = u & 7; att::attn_unit(p, bh >> 3, bh & 7, qb, (char*)lds); } }
    SEAM(4);
    if (IN(5)) run_gemm(L, (const bf16_t*)(ws + WS_MIX), (const bf16_t*)(ws + WS_WO), DM, DM, G, bx, EpiF32{(float*)(ws + WS_Y), DM});
    SEAM(5);
    if (IN(6)) p6_postmix(p, gw, ngw, lane);
    SEAM(6);
    if (IN(7)) run_gemm(L, (const bf16_t*)(ws + WS_H), (const bf16_t*)(ws + WS_WUP), DFF, DM, G, bx, EpiRelu2{(bf16_t*)(ws + WS_ACT)});
    SEAM(7);
    if (IN(8)) run_gemm(L, (const bf16_t*)(ws + WS_ACT), (const bf16_t*)(ws + WS_WDN), DM, DFF, G, bx, EpiF32{(float*)(ws + WS_MO), DM});
    SEAM(8);
    if (IN(9)) p9_final(p, gw, ngw, lane);
#undef IN
#undef SEAM
}

extern "C" void kernel_launch(void* const* d_in, const int* in_sizes, int n_in, void* d_out, int out_size, void* d_ws, size_t ws_size, hipStream_t stream) {
    static int grid = 0;
    if (grid == 0) {
        if (n_in != 16 || in_sizes[0] != M * DM || out_size != M * DM || ws_size < WS_END) { fprintf(stderr, "kernel_launch: unexpected shapes (n_in %d, in0 %d, out %d, ws %zu)\n", n_in, n_in > 0 ? in_sizes[0] : -1, out_size, ws_size); grid = -1; return; }
        int dev = 0, cus = 0, per_cu = 0;
        if (hipGetDevice(&dev) != hipSuccess || hipDeviceGetAttribute(&cus, hipDeviceAttributeMultiprocessorCount, dev) != hipSuccess) { grid = -1; return; }
        if (hipFuncSetAttribute((const void*)mk_fwd, hipFuncAttributeMaxDynamicSharedMemorySize, LDS_TOTAL) != hipSuccess) { fprintf(stderr, "kernel_launch: hipFuncSetAttribute failed\n"); grid = -1; return; }
        if (hipOccupancyMaxActiveBlocksPerMultiprocessor(&per_cu, (const void*)mk_fwd, NWAVES * 64, LDS_TOTAL) != hipSuccess || per_cu < 1) { fprintf(stderr, "kernel_launch: occupancy query says %d blocks per CU\n", per_cu); (void)hipGetLastError(); grid = -1; return; }
        grid = cus;
    }
    if (grid < 0) return;
    Args a{};
    const float** f = (const float**)&a.p;
    for (int i = 0; i < 16; ++i) f[i] = (const float*)d_in[i];
    a.p.out = (float*)d_out; a.p.ws = (unsigned char*)d_ws;
    for (int i = 0; i < 32; ++i) a.p.inv_freq[i] = pow(10000.0, -(2.0 * i) / 64.0);
    (void)hipMemsetAsync((char*)d_ws + WS_CTL, 0, CTL_ZERO_BYTES, stream);
#if MK_PER_PHASE
    for (int ph = 0; ph < NPHASE; ++ph) {
#if MK_NAIVE_ATTN
        if (ph == 4) { hipLaunchKernelGGL(nattn, dim3(M * NH / 4), dim3(256), 0, stream, a.p); continue; }
#endif
        a.ph_lo = ph; a.ph_hi = ph + 1; a.li = ph;
        hipLaunchKernelGGL(mk_fwd, dim3(grid), dim3(NWAVES * 64), LDS_TOTAL, stream, a);
    }
#else
    a.ph_lo = 0; a.ph_hi = NPHASE; a.li = 0;
    hipLaunchKernelGGL(mk_fwd, dim3(grid), dim3(NWAVES * 64), LDS_TOTAL, stream, a);
#endif
    const hipError_t le = hipPeekAtLastError();
    if (le != hipSuccess) fprintf(stderr, "kernel_launch: launch failed: %s\n", hipGetErrorName(le));
}
```

```cpp
#include <hip/hip_runtime.h>
#include <cstdint>
#include <cstdio>
#include <cmath>

constexpr int M = 8192, DM = 2048, SEQ = 2048;
constexpr int CW = 1024, QR = 768, KVR = 512, RD = 64, NH = 8, NOPE = 128, VD = 128, QKD = 192;
constexpr int INW = 4416, INWP = 4608, DFF = 8192, NQ = NH * QKD  , NKV = NH * (NOPE + VD)  ;
constexpr float EPS = 1e-6f;
constexpr float QSCALE = 0.07216878364870322f * 1.4426950408889634f;

constexpr size_t MiB = 1u << 20;
constexpr size_t WS_CTL = 0, WS_TAB = MiB / 4;
constexpr size_t WS_WDN = 1 * MiB, WS_WUP = 33 * MiB, WS_H = 65 * MiB;
constexpr size_t WS_BIG = 97 * MiB;
constexpr size_t WS_PROJ = WS_BIG, WS_MIX = 169 * MiB, WS_CQN = 201 * MiB, WS_CKVN = 213 * MiB, WS_KROPE = 221 * MiB;
constexpr size_t WS_Q = WS_BIG, WS_KN = 121 * MiB, WS_V = 137 * MiB;
constexpr size_t WS_Y = WS_BIG, WS_ACT = WS_BIG, WS_MO = 33 * MiB;
constexpr size_t WS_WIN = 225 * MiB, WS_WO = 243 * MiB, WS_WUQ = 251 * MiB, WS_WUKV = WS_WUQ + (size_t)NQ * QR * 2;
constexpr size_t WS_END = WS_WUKV + (size_t)NKV * KVR * 2;
static_assert(WS_END <= 256 * MiB, "ws map");

typedef unsigned short bf16_t;
typedef float f32x4 __attribute__((ext_vector_type(4)));
typedef float f32x2 __attribute__((ext_vector_type(2)));
typedef unsigned u32x4 __attribute__((ext_vector_type(4)));
typedef unsigned u32x2 __attribute__((ext_vector_type(2)));
#define LAS __attribute__((address_space(3)))
#define GAS __attribute__((address_space(1)))
typedef LAS float lds_float;

struct Params {
    const float* x; const float* pre_mix_g; const float* w_in; const float* conv_w; const float* q_norm_g; const float* w_uq;
    const float* kv_norm_g; const float* w_ukv; const float* conv_out_g; const float* attn_out_g; const float* w_o;
    const float* post_mix_g; const float* pre_mlp_g; const float* w_up; const float* w_down; const float* post_mlp_g;
    float* out; unsigned char* ws;
    double inv_freq[32];
};

__device__ __forceinline__ unsigned f2bf(float f) { unsigned u = __float_as_uint(f); return (u + 0x7fffu + ((u >> 16) & 1u)) >> 16; }
__device__ __forceinline__ unsigned pk2(float lo, float hi) { return f2bf(lo) | (f2bf(hi) << 16); }
__device__ __forceinline__ float bflo(unsigned w) { return __uint_as_float(w << 16); }
__device__ __forceinline__ float bfhi(unsigned w) { return __uint_as_float(w & 0xffff0000u); }
__device__ __forceinline__ float bf1(bf16_t h) { return __uint_as_float(((unsigned)h) << 16); }
__device__ __forceinline__ void unpack8(u32x4 w, float (&v)[8]) {
    v[0] = bflo(w.x); v[1] = bfhi(w.x); v[2] = bflo(w.y); v[3] = bfhi(w.y); v[4] = bflo(w.z); v[5] = bfhi(w.z); v[6] = bflo(w.w); v[7] = bfhi(w.w); }
__device__ __forceinline__ u32x4 pack8(const float (&v)[8]) { u32x4 w; w.x = pk2(v[0], v[1]); w.y = pk2(v[2], v[3]); w.z = pk2(v[4], v[5]); w.w = pk2(v[6], v[7]); return w; }
__device__ __forceinline__ int lane_id_v() { int l; asm volatile("v_mbcnt_lo_u32_b32 %0, -1, 0\n\tv_mbcnt_hi_u32_b32 %0, -1, %0" : "=v"(l)); return l; }
__device__ __forceinline__ float wave_sum(float v) {
#pragma unroll
    for (int o = 1; o < 64; o <<= 1) v += __shfl_xor(v, o);
    return v;
}
__device__ __forceinline__ float wave_max(float v) {
#pragma unroll
    for (int o = 1; o < 64; o <<= 1) v = fmaxf(v, __shfl_xor(v, o));
    return v;
}

__device__ __forceinline__ int uq_row(int n) {
    const int head = n / QKD, w = n % QKD;
    if (w < NOPE) return n;
    const int r = w - NOPE, half = r >> 5, i = r & 31;
    return head * QKD + NOPE + 8 * (i >> 2) + 4 * half + (i & 3);
}
template <bool QPERM>
__device__ __forceinline__ void transpose_item(const float* __restrict__ W, int K, int N, bf16_t* __restrict__ WT, lds_float* scr, int item, int lane) {
    const int nblk = N / 32, kb = item / nblk, nb = item % nblk, k0 = 64 * kb, n0 = 32 * nb;
#pragma unroll
    for (int i = 0; i < 32; ++i) { const int kk = 2 * i + (lane >> 5); scr[kk * 33 + (lane & 31)] = W[(size_t)(k0 + kk) * N + n0 + (lane & 31)]; }
    __builtin_amdgcn_s_waitcnt(0xC07F); asm volatile("" ::: "memory");
    const int c = lane & 7;
#pragma unroll
    for (int j = 0; j < 4; ++j) { const int n = (lane >> 3) + 8 * j; const lds_float* s = scr + (8 * c) * 33 + n;
        u32x4 o; o.x = pk2(s[0 * 33], s[1 * 33]); o.y = pk2(s[2 * 33], s[3 * 33]); o.z = pk2(s[4 * 33], s[5 * 33]); o.w = pk2(s[6 * 33], s[7 * 33]);
        const int orow = QPERM ? uq_row(n0 + n) : (n0 + n);
        *(u32x4*)(WT + (size_t)orow * K + k0 + 8 * c) = o; }
    __builtin_amdgcn_s_waitcnt(0xC07F); asm volatile("" ::: "memory");
}
constexpr int I_IN = (DM / 64) * (INW / 32), I_UQ = (QR / 64) * (NQ / 32), I_UKV = (KVR / 64) * (NKV / 32), I_O = (DM / 64) * (DM / 32),
              I_UP = (DM / 64) * (DFF / 32), I_DN = (DFF / 64) * (DM / 32);
constexpr int IT_UQ = I_IN, IT_UKV = IT_UQ + I_UQ, IT_O = IT_UKV + I_UKV, IT_UP = IT_O + I_O, IT_DN = IT_UP + I_UP, IT_END = IT_DN + I_DN;
__device__ __forceinline__ void conv_item(const Params& p, lds_float* scr, int it, int lane) {
    if (it < IT_UQ) transpose_item<false>(p.w_in, DM, INW, (bf16_t*)(p.ws + WS_WIN), scr, it, lane);
    else if (it < IT_UKV) transpose_item<true>(p.w_uq, QR, NQ, (bf16_t*)(p.ws + WS_WUQ), scr, it - IT_UQ, lane);
    else if (it < IT_O) transpose_item<false>(p.w_ukv, KVR, NKV, (bf16_t*)(p.ws + WS_WUKV), scr, it - IT_UKV, lane);
    else if (it < IT_UP) transpose_item<false>(p.w_o, DM, DM, (bf16_t*)(p.ws + WS_WO), scr, it - IT_O, lane);
    else if (it < IT_DN) transpose_item<false>(p.w_up, DM, DFF, (bf16_t*)(p.ws + WS_WUP), scr, it - IT_UP, lane);
    else transpose_item<false>(p.w_down, DFF, DM, (bf16_t*)(p.ws + WS_WDN), scr, it - IT_DN, lane);
}
__device__ __forceinline__ void conv_range(const Params& p, lds_float* scr, int first, int last, int widx, int nw, int lane) {
    for (int it = first + widx; it < last; it += nw) conv_item(p, scr, it, lane);
}
__device__ __forceinline__ void zero_win_pad(const Params& p, int gw, int ngw, int lane) {
    bf16_t* WinT = (bf16_t*)(p.ws + WS_WIN);
    for (int c = gw * 64 + lane; c < (INWP - INW) * DM / 8; c += ngw * 64) ((u32x4*)(WinT + (size_t)INW * DM))[c] = (u32x4){0u, 0u, 0u, 0u};
}
__device__ __forceinline__ void p0_table(const Params& p, int gtid, int ngt) {
    f32x2* tab = (f32x2*)(p.ws + WS_TAB);
    for (int e = gtid; e < SEQ * 32; e += ngt) {
        const int pos = e >> 5, i = e & 31;
        const double a = (double)pos * p.inv_freq[i];
        const double kq = __builtin_rint(a * 0.63661977236758134308);
        const double r = __builtin_fma(-kq, 1.57079632679489661923, a) - kq * 6.123233995736766e-17;
        const double r2 = r * r;
        double s = -1.0 / 39916800.0; s = s * r2 + 1.0 / 362880.0; s = s * r2 - 1.0 / 5040.0; s = s * r2 + 1.0 / 120.0; s = s * r2 - 1.0 / 6.0; s = s * r2 * r + r;
        double c = 1.0 / 479001600.0; c = c * r2 - 1.0 / 3628800.0; c = c * r2 + 1.0 / 40320.0; c = c * r2 - 1.0 / 720.0; c = c * r2 + 1.0 / 24.0; c = c * r2 - 0.5; c = c * r2 + 1.0;
        const int q = ((int)(long long)kq) & 3;
        double cs, sn;
        if (q == 0) { cs = c; sn = s; } else if (q == 1) { cs = -s; sn = c; } else if (q == 2) { cs = -c; sn = -s; } else { cs = s; sn = -c; }
        tab[e] = (f32x2){(float)cs, (float)sn};
    }
}
__device__ __forceinline__ void rms_rows_2048(const float* __restrict__ x, const float* __restrict__ g, bf16_t* __restrict__ o, int gw, int ngw, int lane) {
    f32x4 gv[8];
#pragma unroll
    for (int j = 0; j < 8; ++j) gv[j] = ((const f32x4*)g)[lane + 64 * j];
    for (int m = gw; m < M; m += ngw) {
        const f32x4* xr = (const f32x4*)(x + (size_t)m * DM) + lane; f32x4 v[8]; float ss = 0.f;
#pragma unroll
        for (int j = 0; j < 8; ++j) { v[j] = xr[64 * j]; ss += (v[j].x * v[j].x + v[j].y * v[j].y) + (v[j].z * v[j].z + v[j].w * v[j].w); }
        const float r = 1.0f / sqrtf(wave_sum(ss) * (1.0f / DM) + EPS);
        u32x2* o8 = (u32x2*)(o + (size_t)m * DM) + lane;
#pragma unroll
        for (int j = 0; j < 8; ++j) { const f32x4 t = v[j] * r * gv[j]; o8[64 * j] = (u32x2){pk2(t.x, t.y), pk2(t.z, t.w)}; }
    }
}

__device__ __forceinline__ void p2_mixprep(const Params& p, int gw, int ngw, int lane) {
    const bf16_t* PROJ = (const bf16_t*)(p.ws + WS_PROJ); bf16_t* MIX = (bf16_t*)(p.ws + WS_MIX); bf16_t* CQN = (bf16_t*)(p.ws + WS_CQN);
    bf16_t* CKVN = (bf16_t*)(p.ws + WS_CKVN); bf16_t* KROPE = (bf16_t*)(p.ws + WS_KROPE); const f32x2* tab = (const f32x2*)(p.ws + WS_TAB);
    const int c0 = 16 * lane;
    for (int m = gw; m < M; m += ngw) {
        const int t = m & (SEQ - 1);
        const bf16_t* pr = PROJ + (size_t)m * INWP;
        {
            float y[16];
#pragma unroll
            for (int hh = 0; hh < 2; ++hh) {
                const int c = c0 + 8 * hh;
                float u0[8], g0[8], cc0[8], u1[8], cc1[8], u2[8], cc2[8];
                unpack8(*(const u32x4*)(pr + c), u0); unpack8(*(const u32x4*)(pr + CW + c), g0); unpack8(*(const u32x4*)(pr + 2 * CW + c), cc0);
                if (t >= 1) { unpack8(*(const u32x4*)(pr - INWP + c), u1); unpack8(*(const u32x4*)(pr - INWP + 2 * CW + c), cc1); }
                else {
#pragma unroll
                    for (int e = 0; e < 8; ++e) { u1[e] = 0.f; cc1[e] = 0.f; } }
                if (t >= 2) { unpack8(*(const u32x4*)(pr - 2 * INWP + c), u2); unpack8(*(const u32x4*)(pr - 2 * INWP + 2 * CW + c), cc2); }
                else {
#pragma unroll
                    for (int e = 0; e < 8; ++e) { u2[e] = 0.f; cc2[e] = 0.f; } }
                const f32x4 wa0 = *(const f32x4*)(p.conv_w + c), wa1 = *(const f32x4*)(p.conv_w + c + 4);
                const f32x4 wb0 = *(const f32x4*)(p.conv_w + CW + c), wb1 = *(const f32x4*)(p.conv_w + CW + c + 4);
                const f32x4 wc0 = *(const f32x4*)(p.conv_w + 2 * CW + c), wc1 = *(const f32x4*)(p.conv_w + 2 * CW + c + 4);
#pragma unroll
                for (int e = 0; e < 8; ++e) {
                    const float w0 = e < 4 ? wa0[e & 3] : wa1[e & 3], w1 = e < 4 ? wb0[e & 3] : wb1[e & 3], w2 = e < 4 ? wc0[e & 3] : wc1[e & 3];
                    y[8 * hh + e] = g0[e] * (w0 * (cc2[e] * u2[e]) + w1 * (cc1[e] * u1[e]) + w2 * (cc0[e] * u0[e]));
                }
            }
            float ss = 0.f;
#pragma unroll
            for (int e = 0; e < 16; ++e) ss += y[e] * y[e];
            ss += __shfl_xor(ss, 1); ss += __shfl_xor(ss, 2); ss += __shfl_xor(ss, 4);
            const float r = 1.0f / sqrtf(ss * (1.0f / 128.0f) + EPS);
#pragma unroll
            for (int hh = 0; hh < 2; ++hh) {
                const int c = c0 + 8 * hh; const f32x4 ga = *(const f32x4*)(p.conv_out_g + c), gb = *(const f32x4*)(p.conv_out_g + c + 4);
                float o[8];
#pragma unroll
                for (int e = 0; e < 8; ++e) o[e] = y[8 * hh + e] * r * (e < 4 ? ga[e & 3] : gb[e & 3]);
                *(u32x4*)(MIX + (size_t)m * DM + c) = pack8(o);
            }
        }
        {
            float a[8], b[8]; unpack8(*(const u32x4*)(pr + 3 * CW + 8 * lane), a);
            const bool two = lane < 32;
            if (two) unpack8(*(const u32x4*)(pr + 3 * CW + 8 * (64 + lane)), b);
            else {
#pragma unroll
                for (int e = 0; e < 8; ++e) b[e] = 0.f; }
            float ss = 0.f;
#pragma unroll
            for (int e = 0; e < 8; ++e) ss += a[e] * a[e] + b[e] * b[e];
            const float r = 1.0f / sqrtf(wave_sum(ss) * (1.0f / QR) + EPS);
            { const f32x4 ga = *(const f32x4*)(p.q_norm_g + 8 * lane), gb = *(const f32x4*)(p.q_norm_g + 8 * lane + 4); float o[8];
#pragma unroll
              for (int e = 0; e < 8; ++e) o[e] = a[e] * r * (e < 4 ? ga[e & 3] : gb[e & 3]);
              *(u32x4*)(CQN + (size_t)m * QR + 8 * lane) = pack8(o); }
            if (two) { const int cc = 8 * (64 + lane); const f32x4 ga = *(const f32x4*)(p.q_norm_g + cc), gb = *(const f32x4*)(p.q_norm_g + cc + 4); float o[8];
#pragma unroll
              for (int e = 0; e < 8; ++e) o[e] = b[e] * r * (e < 4 ? ga[e & 3] : gb[e & 3]);
              *(u32x4*)(CQN + (size_t)m * QR + cc) = pack8(o); }
        }
        {
            float a[8]; unpack8(*(const u32x4*)(pr + 3 * CW + QR + 8 * lane), a); float ss = 0.f;
#pragma unroll
            for (int e = 0; e < 8; ++e) ss += a[e] * a[e];
            const float r = 1.0f / sqrtf(wave_sum(ss) * (1.0f / KVR) + EPS);
            const f32x4 ga = *(const f32x4*)(p.kv_norm_g + 8 * lane), gb = *(const f32x4*)(p.kv_norm_g + 8 * lane + 4); float o[8];
#pragma unroll
            for (int e = 0; e < 8; ++e) o[e] = a[e] * r * (e < 4 ? ga[e & 3] : gb[e & 3]);
            *(u32x4*)(CKVN + (size_t)m * KVR + 8 * lane) = pack8(o);
        }
        {
            const float xv = bf1(pr[3 * CW + QR + KVR + lane]); const float pv = __shfl_xor(xv, 32);
            const f32x2 cs = tab[t * 32 + (lane & 31)];
            const float o = lane < 32 ? (xv * cs.x - pv * cs.y) : (xv * cs.x + pv * cs.y);
            KROPE[(size_t)m * RD + lane] = (bf16_t)f2bf(o);
        }
    }
}

__device__ __forceinline__ void p6_postmix(const Params& p, int gw, int ngw, int lane) {
    const float* Y = (const float*)(p.ws + WS_Y); bf16_t* H = (bf16_t*)(p.ws + WS_H);
    for (int m = gw; m < M; m += ngw) {
        const f32x4* yr = (const f32x4*)(Y + (size_t)m * DM) + lane; const f32x4* xr = (const f32x4*)(p.x + (size_t)m * DM) + lane;
        f32x4 v[8]; float ss = 0.f;
#pragma unroll
        for (int j = 0; j < 8; ++j) { v[j] = yr[64 * j]; ss += (v[j].x * v[j].x + v[j].y * v[j].y) + (v[j].z * v[j].z + v[j].w * v[j].w); }
        const float r1 = 1.0f / sqrtf(wave_sum(ss) * (1.0f / DM) + EPS);
        float s2 = 0.f; f32x4* orow = (f32x4*)(p.out + (size_t)m * DM) + lane;
#pragma unroll
        for (int j = 0; j < 8; ++j) { const f32x4 g = ((const f32x4*)p.post_mix_g)[lane + 64 * j]; v[j] = xr[64 * j] + v[j] * r1 * g; orow[64 * j] = v[j];
            s2 += (v[j].x * v[j].x + v[j].y * v[j].y) + (v[j].z * v[j].z + v[j].w * v[j].w); }
        const float r2 = 1.0f / sqrtf(wave_sum(s2) * (1.0f / DM) + EPS);
        u32x2* o8 = (u32x2*)(H + (size_t)m * DM) + lane;
#pragma unroll
        for (int j = 0; j < 8; ++j) { const f32x4 g = ((const f32x4*)p.pre_mlp_g)[lane + 64 * j]; const f32x4 t = v[j] * r2 * g; o8[64 * j] = (u32x2){pk2(t.x, t.y), pk2(t.z, t.w)}; }
    }
}
__device__ __forceinline__ void p9_final(const Params& p, int gw, int ngw, int lane) {
    const float* MO = (const float*)(p.ws + WS_MO);
    for (int m = gw; m < M; m += ngw) {
        const f32x4* yr = (const f32x4*)(MO + (size_t)m * DM) + lane; f32x4* orow = (f32x4*)(p.out + (size_t)m * DM) + lane;
        f32x4 v[8]; float ss = 0.f;
#pragma unroll
        for (int j = 0; j < 8; ++j) { v[j] = yr[64 * j]; ss += (v[j].x * v[j].x + v[j].y * v[j].y) + (v[j].z * v[j].z + v[j].w * v[j].w); }
        const float r1 = 1.0f / sqrtf(wave_sum(ss) * (1.0f / DM) + EPS);
#pragma unroll
        for (int j = 0; j < 8; ++j) { const f32x4 g = ((const f32x4*)p.post_mlp_g)[lane + 64 * j]; orow[64 * j] = orow[64 * j] + v[j] * r1 * g; }
    }
}

struct EpiProj { bf16_t* O; __device__ __forceinline__ void operator()(int row, int col, const float (&v)[8]) const { *(u32x4*)(O + (size_t)row * INWP + col) = pack8(v); } };
struct EpiKV { bf16_t* KN; bf16_t* V;
    __device__ __forceinline__ void operator()(int row, int col, const float (&v)[8]) const {
        const int head = col >> 8, w = col & 255;
        bf16_t* dst = KN + (size_t)(w >> 7) * ((WS_V - WS_KN) / 2) + (size_t)row * (NH * NOPE) + head * NOPE + (w & 127); *(u32x4*)dst = pack8(v); } };
struct EpiQ { bf16_t* Q; const f32x2* tab;
    __device__ __forceinline__ void operator()(int row, int col, const float (&v)[8]) const {
        const int head = col / QKD, w = col - head * QKD; bf16_t* dst = Q + (size_t)row * NQ + head * QKD;
        if (w < NOPE) { float o[8];
#pragma unroll
            for (int e = 0; e < 8; ++e) o[e] = v[e] * QSCALE;
            *(u32x4*)(dst + w) = pack8(o); }
        else { const int g = (w - NOPE) >> 3, pos = row & (SEQ - 1); const f32x4* tp = (const f32x4*)(tab + pos * 32 + 4 * g); const f32x4 t0 = tp[0], t1 = tp[1];
            const float c[4] = {t0.x, t0.z, t1.x, t1.z}, s[4] = {t0.y, t0.w, t1.y, t1.w}; float o1[4], o2[4];
#pragma unroll
            for (int e = 0; e < 4; ++e) { o1[e] = (v[e] * c[e] - v[4 + e] * s[e]) * QSCALE; o2[e] = (v[4 + e] * c[e] + v[e] * s[e]) * QSCALE; }
            *(u32x2*)(dst + NOPE + 4 * g) = (u32x2){pk2(o1[0], o1[1]), pk2(o1[2], o1[3])};
            *(u32x2*)(dst + NOPE + 32 + 4 * g) = (u32x2){pk2(o2[0], o2[1]), pk2(o2[2], o2[3])}; }
    } };
struct EpiF32 { float* O; int ld;
    __device__ __forceinline__ void operator()(int row, int col, const float (&v)[8]) const {
        f32x4* d = (f32x4*)(O + (size_t)row * ld + col); d[0] = (f32x4){v[0], v[1], v[2], v[3]}; d[1] = (f32x4){v[4], v[5], v[6], v[7]}; } };
struct EpiRelu2 { bf16_t* O;
    __device__ __forceinline__ void operator()(int row, int col, const float (&v)[8]) const { float o[8];
#pragma unroll
        for (int e = 0; e < 8; ++e) { const float r = fmaxf(v[e], 0.f); o[e] = r * r; }
        *(u32x4*)(O + (size_t)row * DFF + col) = pack8(o); } };

template <class Epi>
__global__ __launch_bounds__(256) void ngemm(const bf16_t* __restrict__ A, const bf16_t* __restrict__ Bt, int K, Epi E) {
    __shared__ __attribute__((aligned(16))) float As[32][68];
    __shared__ __attribute__((aligned(16))) float Bs[32][132];
    const int tid = threadIdx.x, ty = tid >> 4, tx = tid & 15, m0 = blockIdx.y * 64, n0 = blockIdx.x * 128;
    float acc[4][8];
#pragma unroll
    for (int i = 0; i < 4; ++i)
#pragma unroll
        for (int j = 0; j < 8; ++j) acc[i][j] = 0.f;
    for (int k0 = 0; k0 < K; k0 += 32) {
        { const int row = tid >> 2, kc = (tid & 3) * 8; float a[8]; unpack8(*(const u32x4*)(A + (size_t)(m0 + row) * K + k0 + kc), a);
#pragma unroll
          for (int e = 0; e < 8; ++e) As[kc + e][row] = a[e]; }
#pragma unroll
        for (int i = 0; i < 2; ++i) { const int idx = tid + 256 * i, row = idx >> 2, kc = (idx & 3) * 8; float b[8]; unpack8(*(const u32x4*)(Bt + (size_t)(n0 + row) * K + k0 + kc), b);
#pragma unroll
          for (int e = 0; e < 8; ++e) Bs[kc + e][row] = b[e]; }
        __syncthreads();
#pragma unroll 8
        for (int k = 0; k < 32; ++k) {
            const f32x4 a4 = *(const f32x4*)&As[k][ty * 4]; const f32x4 b0 = *(const f32x4*)&Bs[k][tx * 8], b1 = *(const f32x4*)&Bs[k][tx * 8 + 4];
#pragma unroll
            for (int i = 0; i < 4; ++i) {
#pragma unroll
                for (int j = 0; j < 4; ++j) { acc[i][j] += a4[i] * b0[j]; acc[i][4 + j] += a4[i] * b1[j]; } }
        }
        __syncthreads();
    }
#pragma unroll
    for (int i = 0; i < 4; ++i) E(m0 + ty * 4 + i, n0 + tx * 8, acc[i]);
}

__global__ __launch_bounds__(256) void nattn(Params p) {
    __shared__ float qs_[4][QKD]; __shared__ float ps_[4][SEQ];
    const int lane = threadIdx.x & 63, w = threadIdx.x >> 6; const int idx = blockIdx.x * 4 + w; const int m = idx >> 3, h = idx & 7, b = m / SEQ, t = m % SEQ;
    const bf16_t* Q = (const bf16_t*)(p.ws + WS_Q); const bf16_t* KN = (const bf16_t*)(p.ws + WS_KN); const bf16_t* V = (const bf16_t*)(p.ws + WS_V);
    const bf16_t* KR = (const bf16_t*)(p.ws + WS_KROPE); bf16_t* MIX = (bf16_t*)(p.ws + WS_MIX);
    float* qs = qs_[w]; float* ps = ps_[w];
    for (int i = 0; i < 3; ++i) qs[lane + 64 * i] = bf1(Q[(size_t)m * NQ + h * QKD + lane + 64 * i]);
    __syncthreads();
    const int nk = ((t >> 6) + 1) * 64; float mx = -1e30f;
    for (int key = lane; key < nk; key += 64) {
        const size_t km = (size_t)b * SEQ + key; float s = 0.f;
        for (int c = 0; c < 16; ++c) { float kv[8]; unpack8(*(const u32x4*)(KN + km * (NH * NOPE) + h * NOPE + 8 * c), kv);
#pragma unroll
            for (int e = 0; e < 8; ++e) s += qs[8 * c + e] * kv[e]; }
        for (int c = 0; c < 8; ++c) { float kv[8]; unpack8(*(const u32x4*)(KR + km * RD + 8 * c), kv);
#pragma unroll
            for (int e = 0; e < 8; ++e) s += qs[NOPE + 8 * c + e] * kv[e]; }
        ps[key] = s; mx = fmaxf(mx, s);
    }
    mx = wave_max(mx); float l = 0.f;
    for (int key = lane; key < nk; key += 64) { const float e = exp2f(ps[key] - mx); ps[key] = e; l += e; }
    l = wave_sum(l);
    __syncthreads();
    float o0 = 0.f, o1 = 0.f;
    for (int key = 0; key < nk; ++key) { const float pk = ps[key]; const unsigned vv = *(const unsigned*)(V + ((size_t)b * SEQ + key) * (NH * VD) + h * VD + 2 * lane); o0 += pk * bflo(vv); o1 += pk * bfhi(vv); }
    o0 /= l; o1 /= l;
    const float ss = wave_sum(o0 * o0 + o1 * o1); const float r = 1.0f / sqrtf(ss * (1.0f / VD) + EPS);
    const float g0 = p.attn_out_g[h * VD + 2 * lane], g1 = p.attn_out_g[h * VD + 2 * lane + 1];
    *(unsigned*)(MIX + (size_t)m * DM + CW + h * VD + 2 * lane) = pk2(o0 * r * g0, o1 * r * g1);
}

namespace pg8 {
#define PG8_LAS __attribute__((address_space(3)))
typedef unsigned short bf16_t;
typedef short bf16x8 __attribute__((ext_vector_type(8)));
typedef float f32x4 __attribute__((ext_vector_type(4)));
typedef unsigned u32x4 __attribute__((ext_vector_type(4)));
constexpr int BM = 256, BK = 64, HALF = 128, HTB = HALF * BK * 2  , STAGE_BYTES = 8 * HTB, NXCD = 8, WGM = 8;

__host__ __device__ __forceinline__ int lds_byte(int r, int c) { const int st = (r >> 4) * 2 + (c >> 5), rr = r & 15, cc = c & 31, ob = rr * 64 + cc * 2; return st * 1024 + (ob ^ (((ob >> 9) & 1) << 5)); }
__host__ __device__ __forceinline__ void stage_rc(int b, int& R, int& C) { const int st = b / 1024, sb = b % 1024, swz = sb ^ (((sb >> 9) & 1) << 5); R = (st >> 1) * 16 + swz / 64; C = (st & 1) * 32 + (swz % 64) / 2; }
__host__ __device__ __forceinline__ int perm32(int rho) { const int n = rho >> 4, i = rho & 15; return 8 * (i >> 2) + 4 * n + (i & 3); }

struct Unit { int pm, pn; };
struct Gemm { const bf16_t* A; const bf16_t* Bt; int M, N, K; };

struct StaticOrder {
    int nM, nN, nwg, G, c;
    __host__ __device__ void init(int M, int N, int G_, int c_) { nM = M / BM; nN = N / BM; nwg = nM * nN; G = G_; c = c_; }
    __host__ __device__ bool next(int i, Unit& u) const {
        const long L = (long)i * G + c; if (L >= nwg) return false;
        int wgid = (int)L; { const int q = nwg / NXCD, r = nwg % NXCD, xcd = wgid % NXCD, off = wgid / NXCD; wgid = (xcd < r ? xcd * (q + 1) : r * (q + 1) + (xcd - r) * q) + off; }
        const int nig = WGM * nN, gid = wgid / nig, fm = gid * WGM, gsz = (nM - fm) < WGM ? (nM - fm) : WGM;
        u.pm = fm + ((wgid % nig) % gsz); u.pn = (wgid % nig) / gsz; return true;
    }
    __device__ __forceinline__ void a_ready(const Unit&) const {}
    __device__ __forceinline__ void done(const Unit&) const {}
};
__device__ __forceinline__ unsigned cvt_pk_bf16(float lo, float hi) { unsigned r; asm volatile("v_cvt_pk_bf16_f32 %0, %1, %2" : "=v"(r) : "v"(lo), "v"(hi)); return r; }
template <class Epi, class Sched, bool ALIGN_EPI = false, bool SP2 = false>
__device__ __forceinline__ void gemm_phase(PG8_LAS unsigned char* lds, const Gemm g, const Sched& S, const Epi& E, int wave_s) {
    const int lane = lane_id_v(), wid = wave_s, tid = wid * 64 + lane, wr = wid >> 2, wc = wid & 3, fr = lane & 15, fq = lane >> 4;
    const int K = g.K, nt = K / BK;
    unsigned voffA[2], voffB[2];
#pragma unroll
    for (int i = 0; i < 2; ++i) { int R, C; stage_rc(tid * 16 + i * 8192, R, C); const int Rb = Epi::PERM ? ((R & ~31) + perm32(R & 31)) : R;
        voffA[i] = (unsigned)(R * K + C) * 2u; voffB[i] = (unsigned)(Rb * K + C) * 2u; }
    const size_t kstep = (size_t)(BK * 2);
    const size_t hstep = (size_t)HALF * K * 2;
    const size_t tstep = 2 * hstep;
    const unsigned ldsw = (unsigned)wid * 1024u;
    const int aoff = lds_byte(wr * 64 + fr, fq * 8), boff = lds_byte(wc * 32 + fr, fq * 8);
#define PG8_SA(b, h) (((b) * 2 + (h)) * HTB)
#define PG8_SB(b, h) ((4 + (b) * 2 + (h)) * HTB)
#define PG8_STAGE(bufoff, gbase, voff) do { _Pragma("unroll") for (int _i = 0; _i < 2; ++_i) \
        __builtin_amdgcn_global_load_lds((const unsigned*)((const char*)(gbase) + (voff)[_i]), (PG8_LAS unsigned*)(lds + (bufoff) + ldsw + _i * 8192), 16, 0, 0); } while (0)
#define PG8_LDA(dst, b, h) do { _Pragma("unroll") for (int m = 0; m < 4; ++m) _Pragma("unroll") for (int k = 0; k < 2; ++k) dst[m][k] = *(const PG8_LAS bf16x8*)(lds + PG8_SA(b, h) + aoff + m * 2048 + k * 1024); } while (0)
#define PG8_LDB(dst, b, h) do { _Pragma("unroll") for (int n = 0; n < 2; ++n) _Pragma("unroll") for (int k = 0; k < 2; ++k) dst[n][k] = *(const PG8_LAS bf16x8*)(lds + PG8_SB(b, h) + boff + n * 2048 + k * 1024); } while (0)
#define PG8_MMA(ai, bj, At, Bt) do { __builtin_amdgcn_s_setprio(1); _Pragma("unroll") for (int m = 0; m < 4; ++m) _Pragma("unroll") for (int n = 0; n < 2; ++n) _Pragma("unroll") for (int k = 0; k < 2; ++k) \
        acc[ai][bj][m][n] = __builtin_amdgcn_mfma_f32_16x16x32_bf16(Bt[n][k], At[m][k], acc[ai][bj][m][n], 0, 0, 0); __builtin_amdgcn_s_setprio(0); } while (0)
#define PG8_WAIT_V(n) asm volatile("s_waitcnt vmcnt(" #n ")" ::: "memory")
#define PG8_WAIT_L(n) asm volatile("s_waitcnt lgkmcnt(" #n ")" ::: "memory")
#define PG8_BAR __builtin_amdgcn_s_barrier()
#define PG8_SCHED __builtin_amdgcn_sched_barrier(0)
    Unit cur, nxt; int ui = 0;
    if (!S.next(0, cur)) return;
    f32x4 acc[2][2][4][2];
#pragma unroll
    for (int a = 0; a < 2; ++a)
#pragma unroll
        for (int b = 0; b < 2; ++b)
#pragma unroll
            for (int m = 0; m < 4; ++m)
#pragma unroll
                for (int n = 0; n < 2; ++n) acc[a][b][m][n] = (f32x4){0.f, 0.f, 0.f, 0.f};
    bf16x8 At[4][2], B0[2][2], B1[2][2];
    const char* cA = (const char*)g.A + (size_t)cur.pm * tstep; const char* cB = (const char*)g.Bt + (size_t)cur.pn * tstep;
    S.a_ready(cur);
    if constexpr (SP2) {
        PG8_STAGE(PG8_SB(0, 0), cB, voffB); PG8_STAGE(PG8_SB(0, 1), cB + hstep, voffB); PG8_STAGE(PG8_SA(0, 0), cA, voffA); PG8_STAGE(PG8_SA(0, 1), cA + hstep, voffA);
        if (wr == 1) PG8_BAR;
        PG8_WAIT_V(2); PG8_BAR;
        PG8_STAGE(PG8_SB(1, 0), cB + kstep, voffB); PG8_STAGE(PG8_SA(1, 0), cA + kstep, voffA); PG8_STAGE(PG8_SB(1, 1), cB + hstep + kstep, voffB);
        PG8_WAIT_V(6); PG8_BAR;
    } else {
        PG8_STAGE(PG8_SB(0, 0), cB, voffB); PG8_STAGE(PG8_SA(0, 0), cA, voffA); PG8_STAGE(PG8_SB(0, 1), cB + hstep, voffB); PG8_STAGE(PG8_SA(0, 1), cA + hstep, voffA);
        if (wr == 1) PG8_BAR;
        PG8_WAIT_V(4); PG8_BAR;
        PG8_STAGE(PG8_SB(1, 0), cB + kstep, voffB); PG8_STAGE(PG8_SA(1, 0), cA + kstep, voffA); PG8_STAGE(PG8_SB(1, 1), cB + hstep + kstep, voffB);
        PG8_WAIT_V(6); PG8_BAR;
    }
    for (;;) {
        const bool has_next = S.next(ui + 1, nxt);
        const char* nA = has_next ? (const char*)g.A + (size_t)nxt.pm * tstep : cA; const char* nB = has_next ? (const char*)g.Bt + (size_t)nxt.pn * tstep : cB;
        for (int t = 0; t < nt; t += 2) {
            const bool last = (t == nt - 2);
            const char* a1 = cA + (size_t)(t + 1) * kstep;
            const char* a2 = last ? nA : cA + (size_t)(t + 2) * kstep; const char* b2 = last ? nB : cB + (size_t)(t + 2) * kstep;
            const char* a3 = a2 + kstep; const char* b3 = b2 + kstep;
            if (last && has_next) S.a_ready(nxt);
            if constexpr (SP2) {
            PG8_LDB(B0, 0, 0); PG8_LDB(B1, 0, 1); PG8_SCHED; PG8_LDA(At, 0, 0); PG8_STAGE(PG8_SA(1, 1), a1 + hstep, voffA);
            PG8_WAIT_V(8); PG8_WAIT_L(0); PG8_BAR; PG8_MMA(0, 0, At, B0); PG8_MMA(0, 1, At, B1); PG8_BAR; PG8_SCHED;
            PG8_LDA(At, 0, 1); PG8_STAGE(PG8_SB(0, 0), b2, voffB); PG8_STAGE(PG8_SB(0, 1), b2 + hstep, voffB); PG8_STAGE(PG8_SA(0, 0), a2, voffA);
            PG8_WAIT_V(8); PG8_WAIT_L(0); PG8_BAR; PG8_MMA(1, 0, At, B0); PG8_MMA(1, 1, At, B1); PG8_BAR; PG8_SCHED;
            PG8_LDB(B0, 1, 0); PG8_LDB(B1, 1, 1); PG8_SCHED; PG8_LDA(At, 1, 0); PG8_STAGE(PG8_SA(0, 1), a2 + hstep, voffA);
            PG8_WAIT_V(8); PG8_WAIT_L(0); PG8_BAR; PG8_MMA(0, 0, At, B0); PG8_MMA(0, 1, At, B1); PG8_BAR; PG8_SCHED;
            PG8_LDA(At, 1, 1); PG8_STAGE(PG8_SB(1, 0), b3, voffB); PG8_STAGE(PG8_SB(1, 1), b3 + hstep, voffB); PG8_STAGE(PG8_SA(1, 0), a3, voffA);
            PG8_WAIT_V(8); PG8_WAIT_L(0); PG8_BAR; PG8_MMA(1, 0, At, B0); PG8_MMA(1, 1, At, B1); PG8_BAR; PG8_SCHED;
            } else {
            PG8_LDB(B0, 0, 0); PG8_SCHED; PG8_LDA(At, 0, 0); PG8_STAGE(PG8_SA(1, 1), a1 + hstep, voffA);
            PG8_WAIT_L(8); PG8_BAR; PG8_WAIT_L(0); PG8_MMA(0, 0, At, B0); PG8_BAR; PG8_SCHED;
            PG8_LDB(B1, 0, 1); PG8_STAGE(PG8_SB(0, 0), b2, voffB);
            PG8_BAR; PG8_WAIT_L(0); PG8_MMA(0, 1, At, B1); PG8_BAR;
            PG8_LDA(At, 0, 1); PG8_STAGE(PG8_SA(0, 0), a2, voffA);
            PG8_BAR; PG8_WAIT_L(0); PG8_MMA(1, 0, At, B0); PG8_BAR; PG8_SCHED;
            PG8_STAGE(PG8_SB(0, 1), b2 + hstep, voffB);
            PG8_WAIT_V(6); PG8_BAR; PG8_MMA(1, 1, At, B1); PG8_BAR;
            PG8_LDB(B0, 1, 0); PG8_SCHED; PG8_LDA(At, 1, 0); PG8_STAGE(PG8_SA(0, 1), a2 + hstep, voffA);
            PG8_WAIT_L(8); PG8_BAR; PG8_WAIT_L(0); PG8_MMA(0, 0, At, B0); PG8_BAR; PG8_SCHED;
            PG8_LDB(B1, 1, 1); PG8_STAGE(PG8_SB(1, 0), b3, voffB);
            PG8_BAR; PG8_WAIT_L(0); PG8_MMA(0, 1, At, B1); PG8_BAR;
            PG8_LDA(At, 1, 1); PG8_STAGE(PG8_SA(1, 0), a3, voffA);
            PG8_BAR; PG8_WAIT_L(0); PG8_MMA(1, 0, At, B0); PG8_BAR; PG8_SCHED;
            PG8_STAGE(PG8_SB(1, 1), b3 + hstep, voffB);
            PG8_WAIT_V(6); PG8_BAR; PG8_MMA(1, 1, At, B1); PG8_BAR;
            }
        }
        if constexpr (ALIGN_EPI) { if (wr == 0) PG8_BAR; }
        if constexpr (!Epi::AFTER_DRAIN) { E(acc, cur, wr, wc, fr, fq); S.done(cur); }
        if (!has_next) break;
#pragma unroll
        for (int a = 0; a < 2; ++a)
#pragma unroll
            for (int b = 0; b < 2; ++b)
#pragma unroll
                for (int m = 0; m < 4; ++m)
#pragma unroll
                    for (int n = 0; n < 2; ++n) acc[a][b][m][n] = (f32x4){0.f, 0.f, 0.f, 0.f};
        cur = nxt; cA = nA; cB = nB; ++ui;
        if constexpr (ALIGN_EPI) { if (wr == 1) PG8_BAR; }
    }
    PG8_WAIT_V(0);
    if constexpr (!ALIGN_EPI) { if (wr == 0) PG8_BAR; }
    PG8_BAR;
    if constexpr (Epi::AFTER_DRAIN) { E.fused(acc, cur, wr, wc, fr, fq, lds, wid, lane); S.done(cur); }
#undef PG8_SA
#undef PG8_SB
#undef PG8_STAGE
#undef PG8_LDA
#undef PG8_LDB
#undef PG8_MMA
#undef PG8_WAIT_V
#undef PG8_WAIT_L
#undef PG8_BAR
#undef PG8_SCHED
}
}
__device__ __forceinline__ unsigned long long rt() { return __builtin_amdgcn_s_memrealtime(); }
#define XB_TMO      128
#define XB_XCNT(j)  (256  + 64 * (j))
#define XB_XSUB(j)  (1280 + 64 * (j))
#define XB_XGEN(j)  (2304 + 64 * (j))
#define XB_TOP      3328
#define XB_TOPGEN   3392
#define XCD_BAR_WORDS 3456
#define XB_SPIN_CAP (1u << 18)

__device__ __forceinline__ unsigned xb_ld(unsigned* p)              { return __hip_atomic_load(p, __ATOMIC_RELAXED, __HIP_MEMORY_SCOPE_AGENT); }
__device__ __forceinline__ unsigned xb_add(unsigned* p, unsigned v) { return __hip_atomic_fetch_add(p, v, __ATOMIC_RELAXED, __HIP_MEMORY_SCOPE_AGENT); }
__device__ __forceinline__ unsigned xb_xcc_id() { return (unsigned)__builtin_amdgcn_s_getreg((3 << 11) | 20) & 0xFu; }
#define XB_SPIN(cond, bar) do { unsigned _sp = 0; while (cond) { __builtin_amdgcn_s_sleep(1); \
    if ((++_sp & 255u) == 0u) { if (xb_ld(&(bar)[XB_TMO])) break; if (_sp > XB_SPIN_CAP) { atomicAdd(&(bar)[XB_TMO], 1u); break; } } } } while (0)

struct XcdBarrier {
    int w0;
    unsigned* bar; unsigned x;
    volatile LAS unsigned* st;
};

__device__ __forceinline__ XcdBarrier xcd_barrier_post(unsigned* bar, volatile LAS unsigned* st, int wave_s) {
    XcdBarrier b; b.bar = bar; b.x = xb_xcc_id(); b.st = st; b.w0 = (wave_s == 0);
    if (b.w0 && lane_id_v() == 0) (void)xb_add(&bar[XB_XCNT(b.x)], 1u);
    return b;
}
__device__ __forceinline__ void xcd_barrier_complete(unsigned* bar, unsigned x, unsigned& nloc, unsigned& nx) {
    const unsigned G = gridDim.x * gridDim.y * gridDim.z;
    unsigned sum, cnt, mine, sp = 0u;
    for (;;) {
        sum = 0u; cnt = 0u; mine = 0u;
#pragma unroll
        for (unsigned j = 0; j < 16; ++j) { const unsigned c = xb_ld(&bar[XB_XCNT(j)]); sum += c; cnt += (c > 0u) ? 1u : 0u; mine = (j == x) ? c : mine; }
        if (sum == G) break;
        __builtin_amdgcn_s_sleep(1);
        if ((++sp & 255u) == 0u) { if (xb_ld(&bar[XB_TMO])) break; if (sp > XB_SPIN_CAP) { atomicAdd(&bar[XB_TMO], 1u); break; } }
    }
    nloc = mine > 0u ? mine : 1u; nx = cnt > 0u ? cnt : 1u;
}

__device__ __forceinline__ void xcd_barrier(const XcdBarrier& b) {
    asm volatile("s_waitcnt vmcnt(0)" ::: "memory");
    __syncthreads();
    if (b.w0 && lane_id_v() == 0) {
        unsigned* bar = b.bar;
        __builtin_amdgcn_s_waitcnt(0);
        unsigned nloc = b.st[0], nx = b.st[1];
        if (nloc == 0u) { xcd_barrier_complete(bar, b.x, nloc, nx); b.st[0] = nloc; b.st[1] = nx; }
        const unsigned old = xb_add(&bar[XB_XSUB(b.x)], 1u);
        const unsigned gen = old / nloc;
        if (old + 1u == (gen + 1u) * nloc) {
            __builtin_amdgcn_fence(__ATOMIC_RELEASE, "agent");
            asm volatile("s_waitcnt vmcnt(0)" ::: "memory");
            const unsigned og = xb_add(&bar[XB_TOP], 1u);
            const unsigned tg = og / nx;
            if (og + 1u == (tg + 1u) * nx) xb_add(&bar[XB_TOPGEN], 1u);
            else XB_SPIN(xb_ld(&bar[XB_TOPGEN]) == tg, bar);
            __builtin_amdgcn_fence(__ATOMIC_ACQUIRE, "agent");
            xb_add(&bar[XB_XGEN(b.x)], 1u);
            asm volatile("s_waitcnt vmcnt(0)" ::: "memory");
        } else {
            XB_SPIN(xb_ld(&bar[XB_XGEN(b.x)]) == gen, bar);
            __builtin_amdgcn_fence(__ATOMIC_ACQUIRE, "agent");
            asm volatile("s_waitcnt vmcnt(0)" ::: "memory");
        }
    }
    __syncthreads();
}
namespace att {
using bf16x8 = __attribute__((ext_vector_type(8))) short;
using s16x4 = __attribute__((ext_vector_type(4))) short;
using f32x16 = __attribute__((ext_vector_type(16))) float;
constexpr int NW = 8, QBLK = 32, KVBLK = 64;
constexpr int SHM_V = KVBLK * VD * 2, SHM_KN = KVBLK * 272, SHM_KR = KVBLK * 144, SHM_QR = 32 * 144;
constexpr int OFF_V = 0, OFF_KN = 2 * SHM_V, OFF_KR = OFF_KN + 2 * SHM_KN, OFF_WS = OFF_KR + 2 * SHM_KR, OFF_QR = OFF_WS + NW * 64 * 4, LDS_BYTES = OFF_QR + NW * SHM_QR;
static_assert(LDS_BYTES <= 131072 && OFF_KR >= 65536, "attention LDS map");
constexpr float THR2 = 8.0f;
#define KSWZ(row, colB) ((row) * 272 + (colB))
#define RSWZ(row, colB) ((row) * 144 + (colB))
#define SBAR() __builtin_amdgcn_sched_barrier(0)
__device__ __forceinline__ int crow(int r, int hi) { return (r & 3) + 8 * (r >> 2) + 4 * hi; }
__device__ __forceinline__ unsigned cvtpk(float lo, float hi) { unsigned r; asm volatile("v_cvt_pk_bf16_f32 %0, %1, %2" : "=v"(r) : "v"(lo), "v"(hi)); return r; }

__device__ __forceinline__ void partialSM(f32x16& p0, f32x16& p1, float& m_reg, float& mn, float& alpha) {
  float pmax = p0[0];
#pragma unroll
  for (int r = 1; r < 16; ++r) pmax = fmaxf(pmax, p0[r]);
#pragma unroll
  for (int r = 0; r < 16; ++r) pmax = fmaxf(pmax, p1[r]);
  { auto rr = __builtin_amdgcn_permlane32_swap(__float_as_uint(pmax), __float_as_uint(pmax), false, false);
    pmax = fmaxf(__uint_as_float(rr[0]), __uint_as_float(rr[1])); }
  if (__builtin_expect(__all(pmax - m_reg <= THR2), 1)) { mn = m_reg; alpha = 1.f; }
  else { mn = fmaxf(m_reg, pmax); alpha = __builtin_amdgcn_exp2f(m_reg - mn); m_reg = mn; }
#pragma unroll
  for (int r = 0; r < 16; ++r) p0[r] = p0[r] - mn;
#pragma unroll
  for (int r = 0; r < 16; ++r) p1[r] = p1[r] - mn;
#pragma unroll
  for (int r = 0; r < 16; ++r) p0[r] = __builtin_amdgcn_exp2f(p0[r]);
}
__device__ __forceinline__ void finishSM(f32x16& p0, f32x16& p1, float alpha, float& l_reg, bf16x8& pa0, bf16x8& pa1, bf16x8& pa2, bf16x8& pa3) {
#pragma unroll
  for (int r = 0; r < 16; ++r) p1[r] = __builtin_amdgcn_exp2f(p1[r]);
  float ps = 0;
#pragma unroll
  for (int r = 0; r < 16; ++r) ps += p0[r];
#pragma unroll
  for (int r = 0; r < 16; ++r) ps += p1[r];
  { auto rr = __builtin_amdgcn_permlane32_swap(__float_as_uint(ps), __float_as_uint(ps), false, false);
    ps = __uint_as_float(rr[0]) + __uint_as_float(rr[1]); }
  l_reg = l_reg * alpha + ps;
#define PK4(P, BASE, OUT) do { unsigned a0 = cvtpk(P[BASE + 0], P[BASE + 1]), a1 = cvtpk(P[BASE + 2], P[BASE + 3]);   \
    unsigned b0 = cvtpk(P[BASE + 4], P[BASE + 5]), b1 = cvtpk(P[BASE + 6], P[BASE + 7]);                              \
    auto r0 = __builtin_amdgcn_permlane32_swap(a0, b0, false, false); auto r1 = __builtin_amdgcn_permlane32_swap(a1, b1, false, false); \
    u32x4 w = {r0[0], r1[0], r0[1], r1[1]}; OUT = *reinterpret_cast<bf16x8*>(&w); } while (0)
  PK4(p0, 0, pa0); PK4(p0, 8, pa1); PK4(p1, 0, pa2); PK4(p1, 8, pa3);
#undef PK4
}
__device__ __forceinline__ void qkt(f32x16& p0, f32x16& p1, const char* Kn, const char* Kr, const bf16x8* qr, const char* Qr, int r32, int hi) {
  p0 = f32x16{}; p1 = f32x16{};
#pragma unroll
  for (int d0 = 0; d0 < 8; ++d0) { const int cb = (d0 * 16 + hi * 8) * 2;
    const bf16x8 b0 = *reinterpret_cast<const bf16x8*>(Kn + KSWZ(r32, cb));
    const bf16x8 b1 = *reinterpret_cast<const bf16x8*>(Kn + KSWZ(32 + r32, cb));
    p0 = __builtin_amdgcn_mfma_f32_32x32x16_bf16(b0, qr[d0], p0, 0, 0, 0);
    p1 = __builtin_amdgcn_mfma_f32_32x32x16_bf16(b1, qr[d0], p1, 0, 0, 0); }
#pragma unroll
  for (int d0 = 0; d0 < 4; ++d0) { const int cb = (d0 * 16 + hi * 8) * 2;
    const bf16x8 b0 = *reinterpret_cast<const bf16x8*>(Kr + RSWZ(r32, cb));
    const bf16x8 b1 = *reinterpret_cast<const bf16x8*>(Kr + RSWZ(32 + r32, cb));
    const bf16x8 qf = *reinterpret_cast<const bf16x8*>(Qr + RSWZ(r32, cb));
    p0 = __builtin_amdgcn_mfma_f32_32x32x16_bf16(b0, qf, p0, 0, 0, 0);
    p1 = __builtin_amdgcn_mfma_f32_32x32x16_bf16(b1, qf, p1, 0, 0, 0); }
}
__device__ __forceinline__ int v_st(int k, int c) { const int kk = (k & ~0xC) | ((k & 4) << 1) | ((k & 8) >> 1); return ((kk >> 3) * 4 + (c >> 5)) * 512 + ((kk & 7) * 32 + (c & 31)) * 2; }
__device__ __forceinline__ int v_rd_base(int lane) { return ((lane & 3) << 3) | (((lane >> 2) & 3) << 6) | (((lane >> 4) & 1) << 5) | (((lane >> 5) & 1) << 8); }
constexpr int v_rd_off(int d0, int ks, int half) { return d0 * 512 + ks * 4096 + half * 2048; }
template <int OFF> __device__ __forceinline__ s16x4 tr_read(int vb) {
  s16x4 r; asm volatile("ds_read_b64_tr_b16 %0, %1 offset:%2" : "=&v"(r) : "v"(vb), "i"(OFF) : "memory"); return r;
}
template <int D0> __device__ __forceinline__ void pv_one(f32x16& od, int vb, bf16x8 pa0, bf16x8 pa1, bf16x8 pa2, bf16x8 pa3) {
  const s16x4 l0 = tr_read<v_rd_off(D0, 0, 0)>(vb), h0 = tr_read<v_rd_off(D0, 0, 1)>(vb), l1 = tr_read<v_rd_off(D0, 1, 0)>(vb), h1 = tr_read<v_rd_off(D0, 1, 1)>(vb);
  const s16x4 l2 = tr_read<v_rd_off(D0, 2, 0)>(vb), h2 = tr_read<v_rd_off(D0, 2, 1)>(vb), l3 = tr_read<v_rd_off(D0, 3, 0)>(vb), h3 = tr_read<v_rd_off(D0, 3, 1)>(vb);
  asm volatile("s_waitcnt lgkmcnt(0)" ::: "memory"); SBAR();
#define PK(L, H) (bf16x8){L[0], L[1], L[2], L[3], H[0], H[1], H[2], H[3]}
  od = __builtin_amdgcn_mfma_f32_32x32x16_bf16(pa0, PK(l0, h0), od, 0, 0, 0);
  od = __builtin_amdgcn_mfma_f32_32x32x16_bf16(pa1, PK(l1, h1), od, 0, 0, 0);
  od = __builtin_amdgcn_mfma_f32_32x32x16_bf16(pa2, PK(l2, h2), od, 0, 0, 0);
  od = __builtin_amdgcn_mfma_f32_32x32x16_bf16(pa3, PK(l3, h3), od, 0, 0, 0);
#undef PK
}
__device__ __forceinline__ void pv_d0(f32x16* o, int vb, bf16x8 pa0, bf16x8 pa1, bf16x8 pa2, bf16x8 pa3) {
  pv_one<0>(o[0], vb, pa0, pa1, pa2, pa3); pv_one<1>(o[1], vb, pa0, pa1, pa2, pa3); pv_one<2>(o[2], vb, pa0, pa1, pa2, pa3); pv_one<3>(o[3], vb, pa0, pa1, pa2, pa3);
}

__device__ __forceinline__ void attn_unit(const Params& p, int b, int h, int qb, char* lds, int wave_s) {
  const int lane = lane_id_v(), wid = wave_s, tid = wid * 64 + lane, r32 = lane & 31, hi = lane >> 5;
  const bf16_t* Qg = (const bf16_t*)(p.ws + WS_Q); const bf16_t* KNg = (const bf16_t*)(p.ws + WS_KN); const bf16_t* Vg = (const bf16_t*)(p.ws + WS_V);
  const bf16_t* KRg = (const bf16_t*)(p.ws + WS_KROPE); bf16_t* MIX = (bf16_t*)(p.ws + WS_MIX);
  char* V_lds = lds + OFF_V; char* Kn_lds = lds + OFF_KN; char* Kr_lds = lds + OFF_KR;
  float* ws = (float*)(lds + OFF_WS) + wid * 64; float* li_l = ws; float* al_l = ws + 32;
  const long rowbase = (long)b * SEQ; const int q0 = qb * (QBLK * NW);
  const int NT = 4 * qb + 4, nvis = 4 * qb + (wid >> 1) + 1;
  float m_reg = -1e30f, l_reg = 0; f32x16 o[4] = {}; bf16x8 qr[8];
  const bf16_t* Qw = Qg + (rowbase + q0 + wid * QBLK + r32) * NQ + h * QKD + hi * 8;
#pragma unroll
  for (int d0 = 0; d0 < 8; ++d0) qr[d0] = *reinterpret_cast<const bf16x8*>(Qw + d0 * 16);
  char* Qr_lds = lds + OFF_QR + wid * SHM_QR;
#pragma unroll
  for (int d0 = 0; d0 < 4; ++d0) *(bf16x8*)(Qr_lds + RSWZ(r32, (d0 * 16 + hi * 8) * 2)) = *reinterpret_cast<const bf16x8*>(Qw + NOPE + d0 * 16);
  const int sr = tid >> 4, sc = (tid & 15) * 8, vst0 = v_st(sr, sc), vst1 = v_st(32 + sr, sc);
  const int krow = tid >> 3, kcol = (tid & 7) * 8;
  const bf16_t* Vh = Vg + rowbase * (NH * VD) + h * VD; const bf16_t* Kh = KNg + rowbase * (NH * NOPE) + h * NOPE; const bf16_t* Rh = KRg + rowbase * RD;
  const int vb0 = (int)(uintptr_t)V_lds + v_rd_base(lane);
  bf16x8 vs0, vs1, ks0, ks1, rs0;
#define SLOAD(k0) do { vs0 = *reinterpret_cast<const bf16x8*>(&Vh[(long)((k0) + sr) * (NH * VD) + sc]); vs1 = *reinterpret_cast<const bf16x8*>(&Vh[(long)((k0) + 32 + sr) * (NH * VD) + sc]); \
    ks0 = *reinterpret_cast<const bf16x8*>(&Kh[(long)((k0) + sr) * (NH * NOPE) + sc]); ks1 = *reinterpret_cast<const bf16x8*>(&Kh[(long)((k0) + 32 + sr) * (NH * NOPE) + sc]); \
    rs0 = *reinterpret_cast<const bf16x8*>(&Rh[(long)((k0) + krow) * RD + kcol]); } while (0)
#define SWRITE(bb) do { *(bf16x8*)(V_lds + (bb) * SHM_V + vst0) = vs0; *(bf16x8*)(V_lds + (bb) * SHM_V + vst1) = vs1; \
    *(bf16x8*)(Kn_lds + (bb) * SHM_KN + KSWZ(sr, sc * 2)) = ks0; *(bf16x8*)(Kn_lds + (bb) * SHM_KN + KSWZ(32 + sr, sc * 2)) = ks1; \
    *(bf16x8*)(Kr_lds + (bb) * SHM_KR + RSWZ(krow, kcol * 2)) = rs0; } while (0)
#define SWAIT() asm volatile("s_waitcnt vmcnt(0)" ::: "memory")
#define RESC(a) do { if (__any((a) < 1.f)) { if (hi == 0) al_l[r32] = (a); asm volatile("s_waitcnt lgkmcnt(0)" ::: "memory"); \
    _Pragma("unroll") for (int d = 0; d < 4; ++d) _Pragma("unroll") for (int r = 0; r < 16; ++r) o[d][r] *= al_l[crow(r, hi)]; } } while (0)
#define QK(P0, P1, bb, t) do { if ((t) < nvis) qkt(P0, P1, Kn_lds + (bb) * SHM_KN, Kr_lds + (bb) * SHM_KR, qr, Qr_lds, r32, hi); \
    else { _Pragma("unroll") for (int r = 0; r < 16; ++r) { P0[r] = -1e30f; P1[r] = -1e30f; } } } while (0)
#define PV(bb, t) do { if ((t) < nvis) pv_d0(o, vb0 + (bb) * SHM_V, pa0, pa1, pa2, pa3); } while (0)
  f32x16 pA0, pA1, pB0, pB1; float mnA, mnB, alA, alB; bf16x8 pa0, pa1, pa2, pa3;
  SLOAD(0); SWAIT(); SWRITE(0); __syncthreads();
  QK(pA0, pA1, 0, 0); partialSM(pA0, pA1, m_reg, mnA, alA);
  SLOAD(KVBLK);
  SWAIT(); SWRITE(1); __syncthreads();
  for (int j = 1; j + 1 < NT; j += 2) {
    SBAR(); QK(pB0, pB1, 1, j);
    finishSM(pA0, pA1, alA, l_reg, pa0, pa1, pa2, pa3); SBAR();
    SLOAD((j + 1) * KVBLK); SBAR();
    PV(0, j - 1); partialSM(pB0, pB1, m_reg, mnB, alB);
    __syncthreads(); SWAIT(); SWRITE(0);
    RESC(alB); __syncthreads();
    SBAR(); QK(pA0, pA1, 0, j + 1);
    finishSM(pB0, pB1, alB, l_reg, pa0, pa1, pa2, pa3); SBAR();
    SLOAD((j + 2) * KVBLK); SBAR();
    PV(1, j); partialSM(pA0, pA1, m_reg, mnA, alA);
    __syncthreads(); SWAIT(); SWRITE(1);
    RESC(alA); __syncthreads();
  }
  SBAR(); QK(pB0, pB1, 1, NT - 1);
  finishSM(pA0, pA1, alA, l_reg, pa0, pa1, pa2, pa3); SBAR();
  PV(0, NT - 2); partialSM(pB0, pB1, m_reg, mnB, alB);
  __syncthreads(); RESC(alB);
  finishSM(pB0, pB1, alB, l_reg, pa0, pa1, pa2, pa3); SBAR();
  PV(1, NT - 1);
  const int le = lane_id_v();
  const int r32e = le & 31, hie = le >> 5;
  if (hie == 0) li_l[r32e] = l_reg; asm volatile("s_waitcnt lgkmcnt(0)" ::: "memory");
  float gsc[4];
#pragma unroll
  for (int d0 = 0; d0 < 4; ++d0) gsc[d0] = p.attn_out_g[h * VD + d0 * 32 + r32e];
  const float* lrow = li_l + 4 * hie;
#pragma unroll
  for (int r = 0; r < 16; ++r) {
    const float rl = __builtin_amdgcn_rcpf(lrow[(r & 3) + 8 * (r >> 2)]); float s = 0.f;
#pragma unroll
    for (int d0 = 0; d0 < 4; ++d0) { o[d0][r] *= rl; s += o[d0][r] * o[d0][r]; }
    s += __shfl_xor(s, 1); s += __shfl_xor(s, 2); s += __shfl_xor(s, 4); s += __shfl_xor(s, 8); s += __shfl_xor(s, 16);
    const float rn = 1.0f / sqrtf(s * (1.0f / VD) + EPS);
#pragma unroll
    for (int d0 = 0; d0 < 4; ++d0) o[d0][r] *= rn * gsc[d0];
  }
  __syncthreads();
  { bf16_t* stg = (bf16_t*)(lds + wid * 8192);
    bf16_t* sw = stg + (4 * hie) * 128 + r32e;
#pragma unroll
    for (int r = 0; r < 16; ++r) {
#pragma unroll
      for (int d0 = 0; d0 < 4; ++d0) sw[((r & 3) + 8 * (r >> 2)) * 128 + d0 * 32] = (bf16_t)f2bf(o[d0][r]); }
    asm volatile("s_waitcnt lgkmcnt(0)" ::: "memory");
    const int lr = le >> 4, ch = le & 15;
    const bf16_t* sr_ = stg + lr * 128 + ch * 8;
    bf16_t* Ow = MIX + (rowbase + q0 + wid * QBLK + lr) * DM + CW + h * VD + ch * 8;
#pragma unroll
    for (int i = 0; i < 8; ++i) { const u32x4 v = *(const u32x4*)(sr_ + i * 4 * 128); *(u32x4*)(Ow + (long)i * 4 * DM) = v; } }
  __syncthreads();
#undef SLOAD
#undef SWRITE
#undef SWAIT
#undef RESC
#undef QK
#undef PV
}
#undef KSWZ
#undef RSWZ
#undef SBAR
}
#ifndef MK_PER_PHASE
#define MK_PER_PHASE 0
#endif
#ifndef MK_REP
#define MK_REP 0
#endif
#ifndef MK_NAIVE_ATTN
#define MK_NAIVE_ATTN 0
#endif
constexpr int NWAVES = 8, NPHASE = 10;
constexpr int RING_BYTES = 131072, LDSCTL_OFF = RING_BYTES, MISC_OFF = LDSCTL_OFF + 320, LDS_TOTAL = 147456;
constexpr int CW_TMO = 0, CW_BAR = 4096;
constexpr size_t CTL_ZERO_BYTES = 65536;
typedef GAS unsigned gu32;
#define RLX_AGENT __ATOMIC_RELAXED, __HIP_MEMORY_SCOPE_AGENT

template <class F> struct EpiAdapt {
    static constexpr bool PERM = true, AFTER_DRAIN = false; F f;
    __device__ __forceinline__ void operator()(const pg8::f32x4 (&acc)[2][2][4][2], const pg8::Unit& u, int wr, int wc, int fr, int fq) const {
#pragma unroll
        for (int ai = 0; ai < 2; ++ai)
#pragma unroll
            for (int m = 0; m < 4; ++m) { const int row = u.pm * 256 + ai * 128 + wr * 64 + m * 16 + fr;
#pragma unroll
                for (int bj = 0; bj < 2; ++bj) { const int col = u.pn * 256 + bj * 128 + wc * 32 + 8 * fq;
                    const pg8::f32x4 a = acc[ai][bj][m][0], b = acc[ai][bj][m][1]; const float v[8] = {a[0], a[1], a[2], a[3], b[0], b[1], b[2], b[3]};
                    f(row, col, v); } }
    }
};
template <class F> __device__ __forceinline__ void run_gemm(LAS unsigned char* lds, const bf16_t* A, const bf16_t* Bt, int N, int K, int G, int c, int wave_s, const F& f) {
    pg8::Gemm g{A, Bt, M, N, K}; pg8::StaticOrder S; S.init(M, N, G, c); EpiAdapt<F> E{f};
    pg8::gemm_phase<EpiAdapt<F>, pg8::StaticOrder, true, true>(lds, g, S, E, wave_s);
}

struct Args { Params p; int ph_lo, ph_hi, li, pad; };
__global__ void __launch_bounds__(NWAVES * 64, 2) mk_fwd(Args args) {
    extern __shared__ __attribute__((aligned(16))) unsigned char lds[];
    const Params& p = args.p;
    LAS unsigned char* L = (LAS unsigned char*)lds;
    volatile LAS unsigned* MISC = (volatile LAS unsigned*)(L + MISC_OFF);
    const int wave = __builtin_amdgcn_readfirstlane(threadIdx.x >> 6);
    const int G = gridDim.x, bx = blockIdx.x, vcu = (G % 8 == 0) ? (bx % 8) * (G / 8) + bx / 8 : bx;
    const int gw = vcu * NWAVES + wave, ngw = G * NWAVES;
    for (int u = threadIdx.x; u < (LDS_TOTAL - LDSCTL_OFF) / 4; u += NWAVES * 64) ((LAS unsigned*)(L + LDSCTL_OFF))[u] = 0u;
    __syncthreads();
    unsigned* ctl = (unsigned*)(p.ws + WS_CTL);
    XcdBarrier bar; bar.w0 = (wave == 0); bar.bar = ctl + CW_BAR; bar.x = 0; bar.st = nullptr;
    const int lo = args.ph_lo, hi = args.ph_hi;
    if (hi - lo > 1) bar = xcd_barrier_post(ctl + CW_BAR, MISC + 8, wave);
#define IN(k) (lo <= (k) && (k) < hi)
#define REP(k) for (int rep_ = 0; rep_ < 1 + ((MK_REP >> (k)) & 1); ++rep_)
#define SEAM(k) do { if (IN(k) && IN((k) + 1)) xcd_barrier(bar); } while (0)
    unsigned char* ws = p.ws;
    lds_float* scr = (lds_float*)(L + wave * 16384);
    const bool bal = (G == 256);
    if (IN(0)) REP(0) { const int ln = lane_id_v(); conv_range(p, scr, 0, IT_UQ, gw, ngw, ln); zero_win_pad(p, gw, ngw, ln); p0_table(p, bx * (NWAVES * 64) + wave * 64 + ln, G * NWAVES * 64);
                 rms_rows_2048(p.x, p.pre_mix_g, (bf16_t*)(ws + WS_H), gw, ngw, ln); }
    SEAM(0);
    if (IN(1)) REP(1) { run_gemm(L, (const bf16_t*)(ws + WS_H), (const bf16_t*)(ws + WS_WIN), INWP, DM, G, bx, wave, EpiProj{(bf16_t*)(ws + WS_PROJ)});
        const int ln = lane_id_v();
        if (bal) { if (bx >= 64) conv_range(p, scr, IT_UQ, IT_DN, (bx - 64) * NWAVES + wave, (G - 64) * NWAVES, ln); }
        else conv_range(p, scr, IT_UQ, IT_DN, gw, ngw, ln); }
    SEAM(1);
    if (IN(2)) REP(2) p2_mixprep(p, gw, ngw, lane_id_v());
    SEAM(2);
    if (IN(3)) REP(3) { run_gemm(L, (const bf16_t*)(ws + WS_CKVN), (const bf16_t*)(ws + WS_WUKV), NKV, KVR, G, bx, wave, EpiKV{(bf16_t*)(ws + WS_KN), (bf16_t*)(ws + WS_V)});
                 run_gemm(L, (const bf16_t*)(ws + WS_CQN), (const bf16_t*)(ws + WS_WUQ), NQ, QR, G, bx, wave, EpiQ{(bf16_t*)(ws + WS_Q), (const f32x2*)(ws + WS_TAB)}); }
    SEAM(3);
    if (IN(4)) REP(4) { for (int u = vcu; u < NH * 4 * 8; u += G) { const int bh = u >> 3, qb = u & 7; att::attn_unit(p, bh >> 3, bh & 7, qb, (char*)lds, wave); }
        if (bal) { const int bh = vcu >> 3, qb = vcu & 7; const int s0 = (qb == 0 ? 0 : qb == 1 ? 64 : qb == 2 ? 119 : qb == 3 ? 165 : qb == 4 ? 201 : qb == 5 ? 229 : qb == 6 ? 247 : 256);
                   const int s1 = qb == 0 ? 64 : qb == 1 ? 119 : qb == 2 ? 165 : qb == 3 ? 201 : qb == 4 ? 229 : qb == 5 ? 247 : 256;
                   conv_range(p, scr, IT_DN + bh * 256 + s0, IT_DN + bh * 256 + s1, wave, NWAVES, lane_id_v()); }
        else conv_range(p, scr, IT_DN, IT_END, gw, ngw, lane_id_v()); }
    SEAM(4);
    if (IN(5)) REP(5) run_gemm(L, (const bf16_t*)(ws + WS_MIX), (const bf16_t*)(ws + WS_WO), DM, DM, G, bx, wave, EpiF32{(float*)(ws + WS_Y), DM});
    SEAM(5);
    if (IN(6)) REP(6) p6_postmix(p, gw, ngw, lane_id_v());
    SEAM(6);
    if (IN(7)) REP(7) run_gemm(L, (const bf16_t*)(ws + WS_H), (const bf16_t*)(ws + WS_WUP), DFF, DM, G, bx, wave, EpiRelu2{(bf16_t*)(ws + WS_ACT)});
    SEAM(7);
    if (IN(8)) REP(8) run_gemm(L, (const bf16_t*)(ws + WS_ACT), (const bf16_t*)(ws + WS_WDN), DM, DFF, G, bx, wave, EpiF32{(float*)(ws + WS_MO), DM});
    SEAM(8);
    if (IN(9)) p9_final(p, gw, ngw, lane_id_v());
#undef IN
#undef SEAM
}

extern "C" void kernel_launch(void* const* d_in, const int* in_sizes, int n_in, void* d_out, int out_size, void* d_ws, size_t ws_size, hipStream_t stream) {
    static int grid = 0;
    if (grid == 0) {
        if (n_in != 16 || in_sizes[0] != M * DM || out_size != M * DM || ws_size < WS_END) { fprintf(stderr, "kernel_launch: unexpected shapes (n_in %d, in0 %d, out %d, ws %zu)\n", n_in, n_in > 0 ? in_sizes[0] : -1, out_size, ws_size); grid = -1; return; }
        int dev = 0, cus = 0, per_cu = 0;
        if (hipGetDevice(&dev) != hipSuccess || hipDeviceGetAttribute(&cus, hipDeviceAttributeMultiprocessorCount, dev) != hipSuccess) { grid = -1; return; }
        if (hipFuncSetAttribute((const void*)mk_fwd, hipFuncAttributeMaxDynamicSharedMemorySize, LDS_TOTAL) != hipSuccess) { fprintf(stderr, "kernel_launch: hipFuncSetAttribute failed\n"); grid = -1; return; }
        if (hipOccupancyMaxActiveBlocksPerMultiprocessor(&per_cu, (const void*)mk_fwd, NWAVES * 64, LDS_TOTAL) != hipSuccess || per_cu < 1) { fprintf(stderr, "kernel_launch: occupancy query says %d blocks per CU\n", per_cu); (void)hipGetLastError(); grid = -1; return; }
        grid = cus;
    }
    if (grid < 0) return;
    Args a{};
    const float** f = (const float**)&a.p;
    for (int i = 0; i < 16; ++i) f[i] = (const float*)d_in[i];
    a.p.out = (float*)d_out; a.p.ws = (unsigned char*)d_ws;
    for (int i = 0; i < 32; ++i) a.p.inv_freq[i] = pow(10000.0, -(2.0 * i) / 64.0);
    (void)hipMemsetAsync((char*)d_ws + WS_CTL, 0, CTL_ZERO_BYTES, stream);
#if MK_PER_PHASE
    for (int ph = 0; ph < NPHASE; ++ph) {
#if MK_NAIVE_ATTN
        if (ph == 4) { hipLaunchKernelGGL(nattn, dim3(M * NH / 4), dim3(256), 0, stream, a.p); continue; }
#endif
        a.ph_lo = ph; a.ph_hi = ph + 1; a.li = ph;
        hipLaunchKernelGGL(mk_fwd, dim3(grid), dim3(NWAVES * 64), LDS_TOTAL, stream, a);
    }
#else
    a.ph_lo = 0; a.ph_hi = NPHASE; a.li = 0;
    hipLaunchKernelGGL(mk_fwd, dim3(grid), dim3(NWAVES * 64), LDS_TOTAL, stream, a);
#endif
    const hipError_t le = hipPeekAtLastError();
    if (le != hipSuccess) fprintf(stderr, "kernel_launch: launch failed: %s\n", hipGetErrorName(le));
}
```
